# Optimizing an MI355X kernel written in HIP

```python
import math
import jax
import jax.numpy as jnp
from jax import lax
import numpy as np


D_MODEL = 2048
BATCH = 4
SEQ = 2048
DEPTH = 4

CHUNK = 64
A_WIDTH = 1024
A_GROUPS = 4
A_GDIM = A_WIDTH // A_GROUPS
A_BLOCK = 128
B_HEADS = 4
B_HEAD_DIM = 256
B_WIDTH = B_HEADS * B_HEAD_DIM
ROPE_BASE = 10000.0
MAX_POS_OFFSET = 4096
C_WIDTH = 1024
C_GROUP = 16
C_GROUPS = C_WIDTH // C_GROUP
C_STATE = 64
D_HEADS = 8
D_HEAD_DIM = 128
D_WIDTH = D_HEADS * D_HEAD_DIM
CONV_K = 4
N_EXPERT_GROUPS = 4
EXPERTS_PER_GROUP = 4
N_EXPERTS = N_EXPERT_GROUPS * EXPERTS_PER_GROUP
TOP_K = 2
D_FF = 1024
MOE_BLOCK = 256
DN_ALPHA = (2 * DEPTH) ** 0.25
DN_BETA = (8 * DEPTH) ** -0.25
LN_EPS = 1e-5
RMS_EPS = 1e-6
N_EVEN = (DEPTH + 1) // 2
N_ODD = DEPTH // 2
EVEN_SPLITS = (A_WIDTH, A_WIDTH, B_WIDTH, B_WIDTH, B_WIDTH, B_WIDTH)
EVEN_IN = sum(EVEN_SPLITS)
ODD_SPLITS = (C_WIDTH, 3 * D_WIDTH, D_WIDTH, D_HEADS, D_HEADS)
ODD_IN = sum(ODD_SPLITS)

kernel_name = 'hybrid_streaming_encoder_trunk'


def _split(h, sizes):
    return jnp.split(h, np.cumsum(sizes)[:-1].tolist(), axis=-1)


def layer_norm(x, g, b):
    xf = x.astype(jnp.float32)
    mu = xf.mean(-1, keepdims=True)
    var = jnp.square(xf - mu).mean(-1, keepdims=True)
    return ((xf - mu) * lax.rsqrt(var + LN_EPS) * g.astype(jnp.float32) + b.astype(jnp.float32)).astype(x.dtype)


def rms_norm(x, g):
    xf = x.astype(jnp.float32)
    return xf * lax.rsqrt(jnp.mean(xf * xf, -1, keepdims=True) + RMS_EPS) * g.astype(jnp.float32)


def l2norm(x):
    return x * lax.rsqrt(jnp.sum(x * x, -1, keepdims=True) + RMS_EPS)


def to_chunks(x):
    b, l, h, d = x.shape
    return x.reshape(b, l // CHUNK, CHUNK, h, d).transpose(1, 0, 3, 2, 4)


def to_chunks_scalar(x):
    b, l, h = x.shape
    return x.reshape(b, l // CHUNK, CHUNK, h).transpose(1, 0, 3, 2)


def from_chunks(x):
    n, b, h, c, d = x.shape
    return x.transpose(1, 0, 3, 2, 4).reshape(b, n * c, h, d)


def rotary(x, pos):
    half = x.shape[-1] // 2
    inv = ROPE_BASE ** (-jnp.arange(half, dtype=jnp.float32) / half)
    ang = pos.astype(jnp.float32)[:, :, None] * inv
    cos, sin = jnp.cos(ang)[:, :, None, :], jnp.sin(ang)[:, :, None, :]
    x1, x2 = x[..., :half], x[..., half:]
    return jnp.concatenate([x1 * cos - x2 * sin, x1 * sin + x2 * cos], axis=-1)


def gmlp_spatial_gate(u, v, ln_g, ln_b, w_s, b_s):
    bsz, seq, _ = u.shape
    v = layer_norm(v.reshape(bsz, seq, A_GROUPS, A_GDIM),
                   ln_g.reshape(A_GROUPS, A_GDIM), ln_b.reshape(A_GROUPS, A_GDIM))
    v = v.reshape(bsz, seq // A_BLOCK, A_BLOCK, A_GROUPS, A_GDIM)
    cid = jnp.arange(A_BLOCK) // CHUNK
    chunk_causal = (cid[:, None] >= cid[None, :])[None]
    w = jnp.where(chunk_causal, w_s, 0.0).astype(v.dtype)
    s = jnp.einsum('gij,bnjgc->bnigc', w, v) + b_s.T[:, :, None].astype(v.dtype)
    return u * s.reshape(bsz, seq, A_WIDTH)


def retention(q, k, v, pos):
    q = rotary(q, pos) * (B_HEAD_DIM ** -0.5)
    k = rotary(k, pos)
    qc, kc, vc = to_chunks(q), to_chunks(k), to_chunks(v)
    log_gamma = jnp.log1p(-2.0 ** (-5.0 - jnp.arange(B_HEADS, dtype=jnp.float32)))
    i = jnp.arange(CHUNK, dtype=jnp.float32)
    intra = jnp.exp(log_gamma[:, None, None] * jnp.abs(i[:, None] - i[None, :]))
    scores = jnp.einsum('nbhid,nbhjd->nbhij', qc, kc) * intra
    o_intra = jnp.einsum('nbhij,nbhje->nbhie', scores, vc)
    k_dec = jnp.exp(log_gamma[:, None] * (CHUNK - 1.0 - i))
    q_dec = jnp.exp(log_gamma[:, None] * (i + 1.0))
    kv = jnp.einsum('nbhjd,hj,nbhje->nbhde', kc, k_dec, vc)
    chunk_dec = jnp.exp(log_gamma * CHUNK)[:, None, None]

    def step(state, inp):
        q_n, kv_n = inp
        return state * chunk_dec + kv_n, jnp.einsum('bhid,bhde->bhie', q_n, state)

    s0 = jnp.zeros(kv.shape[1:], jnp.float32)
    _, o_inter = lax.scan(step, s0, (qc * q_dec[:, :, None], kv))
    return from_chunks(o_intra + o_inter)


def even_mixer(x, pos, w_in, w_out, a_ln_g, a_ln_b, a_w_s, a_b_s, b_gn_g, b_gn_b):
    bsz, seq, _ = x.shape
    a_u, a_v, r_q, r_k, r_v, r_g = _split(x @ w_in, EVEN_SPLITS)
    y_a = gmlp_spatial_gate(jax.nn.gelu(a_u, approximate=False), jax.nn.gelu(a_v, approximate=False),
                            a_ln_g, a_ln_b, a_w_s, a_b_s)
    heads = lambda t: t.reshape(bsz, seq, B_HEADS, B_HEAD_DIM).astype(jnp.float32)
    o = retention(heads(r_q), heads(r_k), heads(r_v), pos)
    o = layer_norm(o, b_gn_g.reshape(B_HEADS, B_HEAD_DIM), b_gn_b.reshape(B_HEADS, B_HEAD_DIM))
    y_b = jax.nn.silu(r_g) * o.reshape(bsz, seq, B_WIDTH).astype(x.dtype)
    return jnp.concatenate([y_a, y_b], axis=-1) @ w_out


def _complex_affine_combine(e1, e2):
    a1r, a1i, b1r, b1i = e1
    a2r, a2i, b2r, b2i = e2
    return (a2r * a1r - a2i * a1i, a2r * a1i + a2i * a1r,
            a2r * b1r - a2i * b1i + b2r, a2r * b1i + a2i * b1r + b2i)


def s5_layer(u, a_re, a_im, b_re, b_im, c_re, c_im, d_skip, log_step, w_glu, b_glu):
    f32 = jnp.float32
    bsz, seq, _ = u.shape
    ug = u.reshape(bsz, seq, C_GROUPS, C_GROUP).astype(f32)
    a_re, a_im, b_re, b_im, c_re, c_im = (t.astype(f32) for t in (a_re, a_im, b_re, b_im, c_re, c_im))
    dt = jnp.exp(log_step.astype(f32))[:, None]
    mag = jnp.exp(a_re * dt)
    lb_re, lb_im = mag * jnp.cos(a_im * dt), mag * jnp.sin(a_im * dt)
    den = a_re * a_re + a_im * a_im
    f_re = ((lb_re - 1.0) * a_re + lb_im * a_im) / den
    f_im = (lb_im * a_re - (lb_re - 1.0) * a_im) / den
    bb_re = f_re[..., None] * b_re - f_im[..., None] * b_im
    bb_im = f_re[..., None] * b_im + f_im[..., None] * b_re
    bu_re = jnp.einsum('blgc,gpc->blgp', ug, bb_re)
    bu_im = jnp.einsum('blgc,gpc->blgp', ug, bb_im)
    lam_re = jnp.broadcast_to(lb_re, bu_re.shape)
    lam_im = jnp.broadcast_to(lb_im, bu_im.shape)
    _, _, x_re, x_im = lax.associative_scan(_complex_affine_combine, (lam_re, lam_im, bu_re, bu_im), axis=1)
    y = (jnp.einsum('blgp,gcp->blgc', x_re, c_re) - jnp.einsum('blgp,gcp->blgc', x_im, c_im)
         + d_skip.astype(f32) * ug)
    y = jax.nn.gelu(y.reshape(bsz, seq, C_WIDTH), approximate=False).astype(u.dtype)
    return y * jax.nn.sigmoid(y @ w_glu + b_glu)


def causal_depthwise_conv(x, w):
    ch = x.shape[-1]
    return lax.conv_general_dilated(x, w[:, None, :].astype(x.dtype), window_strides=(1,),
                                    padding=[(CONV_K - 1, 0)], dimension_numbers=('NWC', 'WIO', 'NWC'),
                                    feature_group_count=ch)


def chunk_gated_delta_rule(q, k, v, g, beta):
    qc, kc, vc = to_chunks(q), to_chunks(k), to_chunks(v)
    bc = to_chunks_scalar(beta)
    gc = jnp.cumsum(to_chunks_scalar(g), axis=-1)
    idx = jnp.arange(CHUNK)
    incl = idx[:, None] >= idx[None, :]
    strict = idx[:, None] > idx[None, :]
    decay = jnp.exp(jnp.where(incl, gc[..., :, None] - gc[..., None, :], -jnp.inf))
    kb = kc * bc[..., None]
    lower = jnp.where(strict, jnp.einsum('nbhid,nbhjd->nbhij', kb, kc) * decay, 0.0)
    rhs = jnp.concatenate([vc * bc[..., None], kb * jnp.exp(gc)[..., None]], axis=-1)
    sol = lax.linalg.triangular_solve(lower, rhs, left_side=True, lower=True, unit_diagonal=True)
    u_c, w_c = sol[..., :D_HEAD_DIM], sol[..., D_HEAD_DIM:]
    attn = jnp.einsum('nbhid,nbhjd->nbhij', qc, kc) * decay
    q_dec = qc * jnp.exp(gc)[..., None]
    k_dec = kc * jnp.exp(gc[..., -1:] - gc)[..., None]
    g_last = jnp.exp(gc[..., -1])[..., None, None]

    def step(state, inp):
        u_n, w_n, qd_n, kd_n, a_n, gl_n = inp
        v_new = u_n - jnp.einsum('bhcd,bhde->bhce', w_n, state)
        o_n = jnp.einsum('bhcd,bhde->bhce', qd_n, state) + jnp.einsum('bhij,bhje->bhie', a_n, v_new)
        state = state * gl_n + jnp.einsum('bhcd,bhce->bhde', kd_n, v_new)
        return state, o_n

    s0 = jnp.zeros((q.shape[0], D_HEADS, D_HEAD_DIM, D_HEAD_DIM), jnp.float32)
    _, o = lax.scan(step, s0, (u_c, w_c, q_dec, k_dec, attn, g_last))
    return from_chunks(o)


def gated_deltanet(qkv_raw, gate, beta_raw, a_raw, conv_w, a_log, dt_bias, norm_g):
    f32 = jnp.float32
    bsz, seq, _ = qkv_raw.shape
    qkv = jax.nn.silu(causal_depthwise_conv(qkv_raw, conv_w)).astype(f32)
    q, k, v = (t.reshape(bsz, seq, D_HEADS, D_HEAD_DIM) for t in jnp.split(qkv, 3, axis=-1))
    q = l2norm(q) * (D_HEAD_DIM ** -0.5)
    k = l2norm(k)
    beta = jax.nn.sigmoid(beta_raw.astype(f32))
    g = -jnp.exp(a_log.astype(f32)) * jax.nn.softplus(a_raw.astype(f32) + dt_bias.astype(f32))
    o = rms_norm(chunk_gated_delta_rule(q, k, v, g, beta), norm_g)
    return (o.reshape(bsz, seq, D_WIDTH) * jax.nn.silu(gate.astype(f32))).astype(gate.dtype)


def odd_mixer(x, w_in, w_out, c_a_re, c_a_im, c_b_re, c_b_im, c_c_re, c_c_im, c_d, c_log_step,
              c_w_glu, c_b_glu, d_conv_w, d_a_log, d_dt_bias, d_norm_g):
    c_u, d_qkv, d_gate, d_beta, d_a = _split(x @ w_in, ODD_SPLITS)
    y_c = s5_layer(c_u, c_a_re, c_a_im, c_b_re, c_b_im, c_c_re, c_c_im, c_d, c_log_step, c_w_glu, c_b_glu)
    y_d = gated_deltanet(d_qkv, d_gate, d_beta, d_a, d_conv_w, d_a_log, d_dt_bias, d_norm_g)
    return jnp.concatenate([y_c, y_d], axis=-1) @ w_out


def moe_ffn(x, w_router, router_bias, w_in, w_out):
    bsz, seq, dm = x.shape
    n_tok = bsz * seq
    xt = x.reshape(n_tok, dm)
    probs = jax.nn.softmax((xt @ w_router).astype(jnp.float32), axis=-1)
    sel = (probs + router_bias.astype(jnp.float32)).reshape(n_tok, N_EXPERT_GROUPS, EXPERTS_PER_GROUP)
    group_score = lax.top_k(sel, TOP_K)[0].sum(-1)
    grp = jnp.argmax(group_score, axis=-1)
    in_grp = jnp.take_along_axis(sel, grp[:, None, None], axis=1)[:, 0]
    _, local = lax.top_k(in_grp, TOP_K)
    eid = grp[:, None] * EXPERTS_PER_GROUP + local
    gate = jnp.take_along_axis(probs, eid, axis=1)
    gate = gate / gate.sum(-1, keepdims=True)
    n_asg = n_tok * TOP_K
    e_flat = eid.reshape(n_asg)
    order = jnp.argsort(e_flat)
    e_s = e_flat[order]
    tok_s = order // TOP_K
    g_s = gate.reshape(n_asg)[order]
    counts = jnp.bincount(e_flat, length=N_EXPERTS)
    starts = jnp.cumsum(counts) - counts
    padded = (counts + MOE_BLOCK - 1) // MOE_BLOCK * MOE_BLOCK
    p_ends = jnp.cumsum(padded)
    p_starts = p_ends - padded
    dest = p_starts[e_s] + jnp.arange(n_asg) - starts[e_s]
    n_blocks = -(-n_asg // MOE_BLOCK) + N_EXPERTS
    rows = n_blocks * MOE_BLOCK
    xbuf = jnp.zeros((rows, dm), x.dtype).at[dest].set(xt[tok_s])
    block_e = jnp.minimum(jnp.searchsorted(p_ends, jnp.arange(n_blocks) * MOE_BLOCK, side='right'),
                          N_EXPERTS - 1)

    def expert_block(args):
        xb, e = args
        hg, hu = jnp.split(xb @ w_in[e], 2, axis=-1)
        return (jax.nn.silu(hg) * hu) @ w_out[e]

    ybuf = lax.map(expert_block, (xbuf.reshape(n_blocks, MOE_BLOCK, dm), block_e)).reshape(rows, dm)
    y = jnp.zeros((n_tok, dm), x.dtype).at[tok_s].add(ybuf[dest] * g_s[:, None].astype(x.dtype))
    return y.reshape(bsz, seq, dm)


def setup_inputs(seed: int = 0) -> dict:
    key = jax.random.key(seed)
    ks = iter(jax.random.split(key, 40))
    f32 = jnp.float32
    nrm = lambda shape, scale: jax.random.normal(next(ks), shape, f32) * scale
    uni = lambda shape, lo, hi: jax.random.uniform(next(ks), shape, f32, lo, hi)
    ne, no = N_EVEN, N_ODD
    x = nrm((BATCH, SEQ, D_MODEL), 1.0)
    offset = jax.random.randint(next(ks), (BATCH, 1), 0, MAX_POS_OFFSET, jnp.int32)
    positions = offset + jnp.arange(SEQ, dtype=jnp.int32)[None, :]
    w_router = nrm((D_MODEL, N_EXPERTS), D_MODEL ** -0.5)
    router_bias = nrm((N_EXPERTS,), 0.01)
    ln_mix_g = 1.0 + nrm((DEPTH, D_MODEL), 0.02)
    ln_mix_b = nrm((DEPTH, D_MODEL), 0.02)
    ln_ffn_g = 1.0 + nrm((DEPTH, D_MODEL), 0.02)
    ln_ffn_b = nrm((DEPTH, D_MODEL), 0.02)
    moe_w_in = nrm((DEPTH, N_EXPERTS, D_MODEL, 2 * D_FF), D_MODEL ** -0.5)
    moe_w_out = nrm((DEPTH, N_EXPERTS, D_FF, D_MODEL), DN_BETA * D_FF ** -0.5)
    ev_w_in = nrm((ne, D_MODEL, EVEN_IN), D_MODEL ** -0.5)
    ev_w_out = nrm((ne, A_WIDTH + B_WIDTH, D_MODEL), DN_BETA * (A_WIDTH + B_WIDTH) ** -0.5)
    a_ln_g = 1.0 + nrm((ne, A_WIDTH), 0.02)
    a_ln_b = nrm((ne, A_WIDTH), 0.02)
    a_w_s = nrm((ne, A_GROUPS, A_BLOCK, A_BLOCK), A_BLOCK ** -0.5)
    a_b_s = 1.0 + nrm((ne, A_GROUPS, A_BLOCK), 0.02)
    b_gn_g = 1.0 + nrm((ne, B_WIDTH), 0.02)
    b_gn_b = nrm((ne, B_WIDTH), 0.02)
    od_w_in = nrm((no, D_MODEL, ODD_IN), D_MODEL ** -0.5)
    od_w_out = nrm((no, C_WIDTH + D_WIDTH, D_MODEL), DN_BETA * (C_WIDTH + D_WIDTH) ** -0.5)
    c_a_re = -0.5 + nrm((no, C_GROUPS, C_STATE), 0.01)
    c_a_im = jnp.pi * jnp.arange(C_STATE, dtype=f32)[None, None, :] + nrm((no, C_GROUPS, C_STATE), 0.01)
    c_b_re = nrm((no, C_GROUPS, C_STATE, C_GROUP), (2 * C_GROUP) ** -0.5)
    c_b_im = nrm((no, C_GROUPS, C_STATE, C_GROUP), (2 * C_GROUP) ** -0.5)
    c_c_re = nrm((no, C_GROUPS, C_GROUP, C_STATE), C_STATE ** -0.5)
    c_c_im = nrm((no, C_GROUPS, C_GROUP, C_STATE), C_STATE ** -0.5)
    c_d = nrm((no, C_GROUPS, C_GROUP), 1.0)
    c_log_step = uni((no, C_GROUPS), math.log(1e-3), math.log(1e-1))
    c_w_glu = nrm((no, C_WIDTH, C_WIDTH), C_WIDTH ** -0.5)
    c_b_glu = nrm((no, C_WIDTH), 0.02)
    d_conv_w = nrm((no, CONV_K, 3 * D_WIDTH), CONV_K ** -0.5)
    d_a_log = jnp.log(uni((no, D_HEADS), 1.0, 16.0))
    dt = jnp.exp(uni((no, D_HEADS), math.log(1e-3), math.log(1e-1)))
    d_dt_bias = dt + jnp.log(-jnp.expm1(-dt))
    d_norm_g = 1.0 + nrm((no, D_HEAD_DIM), 0.02)
    return {'x': x, 'positions': positions, 'w_router': w_router, 'router_bias': router_bias,
            'ln_mix_g': ln_mix_g, 'ln_mix_b': ln_mix_b, 'ln_ffn_g': ln_ffn_g, 'ln_ffn_b': ln_ffn_b,
            'moe_w_in': moe_w_in, 'moe_w_out': moe_w_out,
            'ev_w_in': ev_w_in, 'ev_w_out': ev_w_out, 'a_ln_g': a_ln_g, 'a_ln_b': a_ln_b,
            'a_w_s': a_w_s, 'a_b_s': a_b_s, 'b_gn_g': b_gn_g, 'b_gn_b': b_gn_b,
            'od_w_in': od_w_in, 'od_w_out': od_w_out, 'c_a_re': c_a_re, 'c_a_im': c_a_im,
            'c_b_re': c_b_re, 'c_b_im': c_b_im, 'c_c_re': c_c_re, 'c_c_im': c_c_im, 'c_d': c_d,
            'c_log_step': c_log_step, 'c_w_glu': c_w_glu, 'c_b_glu': c_b_glu,
            'd_conv_w': d_conv_w, 'd_a_log': d_a_log, 'd_dt_bias': d_dt_bias, 'd_norm_g': d_norm_g}


def reference(x, positions, w_router, router_bias, ln_mix_g, ln_mix_b, ln_ffn_g, ln_ffn_b,
              moe_w_in, moe_w_out, ev_w_in, ev_w_out, a_ln_g, a_ln_b, a_w_s, a_b_s, b_gn_g, b_gn_b,
              od_w_in, od_w_out, c_a_re, c_a_im, c_b_re, c_b_im, c_c_re, c_c_im, c_d, c_log_step,
              c_w_glu, c_b_glu, d_conv_w, d_a_log, d_dt_bias, d_norm_g):
    for layer in range(DEPTH):
        i = layer // 2
        if layer % 2 == 0:
            m = even_mixer(x, positions, ev_w_in[i], ev_w_out[i], a_ln_g[i], a_ln_b[i], a_w_s[i], a_b_s[i],
                           b_gn_g[i], b_gn_b[i])
        else:
            m = odd_mixer(x, od_w_in[i], od_w_out[i], c_a_re[i], c_a_im[i], c_b_re[i], c_b_im[i],
                          c_c_re[i], c_c_im[i], c_d[i], c_log_step[i], c_w_glu[i], c_b_glu[i],
                          d_conv_w[i], d_a_log[i], d_dt_bias[i], d_norm_g[i])
        x = layer_norm(DN_ALPHA * x + m, ln_mix_g[layer], ln_mix_b[layer])
        x = layer_norm(DN_ALPHA * x + moe_ffn(x, w_router, router_bias, moe_w_in[layer], moe_w_out[layer]),
                       ln_ffn_g[layer], ln_ffn_b[layer])
    return x
```

```cpp
#include <hip/hip_runtime.h>
#include <cstdio>
#include <cstdint>

#ifndef MK_ONE_LAUNCH
#define MK_ONE_LAUNCH 1
#endif

namespace pg8 {
#define PG8_LAS __attribute__((address_space(3)))
typedef unsigned short bf16_t;
typedef short bf16x8 __attribute__((ext_vector_type(8)));
typedef float f32x4 __attribute__((ext_vector_type(4)));
typedef float f32x2 __attribute__((ext_vector_type(2)));
typedef unsigned u32x4 __attribute__((ext_vector_type(4)));
typedef unsigned u32x2 __attribute__((ext_vector_type(2)));
constexpr int BM = 256, BK = 64, HALF = 128, HTB = HALF * BK * 2  , STAGE_BYTES = 8 * HTB, NXCD = 8, WGM = 8;

__host__ __device__ __forceinline__ int lds_byte(int r, int c) { const int st = (r >> 4) * 2 + (c >> 5), rr = r & 15, cc = c & 31, ob = rr * 64 + cc * 2; return st * 1024 + (ob ^ (((ob >> 9) & 1) << 5)); }
__host__ __device__ __forceinline__ void stage_rc(int b, int& R, int& C) { const int st = b / 1024, sb = b % 1024, swz = sb ^ (((sb >> 9) & 1) << 5); R = (st >> 1) * 16 + swz / 64; C = (st & 1) * 32 + (swz % 64) / 2; }
__host__ __device__ __forceinline__ int perm32(int rho) { const int n = rho >> 4, i = rho & 15; return 8 * (i >> 2) + 4 * n + (i & 3); }

struct Unit { const char* A; const char* B; int pm, pn, e, rows; };

struct StaticOrder {
    const char* A0; const char* B0; size_t tstep; int nM, nN, nwg, G, c;
    __device__ void init(const void* A, const void* Bt, int K, int nM_, int nN_, int G_, int c_) { A0 = (const char*)A; B0 = (const char*)Bt; tstep = (size_t)BM * K * 2; nM = nM_; nN = nN_; nwg = nM * nN; G = G_; c = c_; }
    __device__ bool next(int i, Unit& u) const {
        const long L = (long)i * G + c; if (L >= nwg) return false;
        int wgid = (int)L; { const int q = nwg / NXCD, r = nwg % NXCD, xcd = wgid % NXCD, off = wgid / NXCD; wgid = (xcd < r ? xcd * (q + 1) : r * (q + 1) + (xcd - r) * q) + off; }
        const int nig = WGM * nN, gid = wgid / nig, fm = gid * WGM, gsz = (nM - fm) < WGM ? (nM - fm) : WGM;
        u.pm = fm + ((wgid % nig) % gsz); u.pn = (wgid % nig) / gsz; u.e = 0; u.rows = BM;
        u.A = A0 + (size_t)u.pm * tstep; u.B = B0 + (size_t)u.pn * tstep; return true;
    }
    __device__ __forceinline__ void a_ready(const Unit&) const {}
    __device__ __forceinline__ void done(const Unit&) const {}
};
struct MoeOrder {
    const PG8_LAS int* tab; const char* A0; const char* B0; size_t a_es, b_es, a_ts, b_ts; int G, c;
    __device__ bool next(int i, Unit& u) const {
        const long uid = (long)i * G + c; const int total = __builtin_amdgcn_readfirstlane(tab[16]) * 8; if (uid >= total) return false;
        const int nt = (int)(uid & 7), v = (int)(uid >> 3); int e = 0;
#pragma unroll
        for (int k = 1; k < 16; ++k) e += (v >= tab[k]) ? 1 : 0;
        e = __builtin_amdgcn_readfirstlane(e);
        const int mt = __builtin_amdgcn_readfirstlane(v - tab[e]);
        const int rows = __builtin_amdgcn_readfirstlane(tab[17 + e]) - mt * BM;
        u.e = e; u.pm = mt; u.pn = nt; u.rows = rows < BM ? rows : BM;
        u.A = A0 + (size_t)e * a_es + (size_t)mt * a_ts; u.B = B0 + (size_t)e * b_es + (size_t)nt * b_ts; return true;
    }
    __device__ __forceinline__ void a_ready(const Unit&) const {}
    __device__ __forceinline__ void done(const Unit&) const {}
};

__device__ __forceinline__ unsigned cvt_pk_bf16(float lo, float hi) { unsigned r; asm volatile("v_cvt_pk_bf16_f32 %0, %1, %2" : "=v"(r) : "v"(lo), "v"(hi)); return r; }
__device__ __forceinline__ f32x2 gelu_pk(f32x2 v) {
    const f32x2 av = __builtin_elementwise_abs(v), d = av * 0.2316418882f + 1.0f;
    f32x2 t; t.x = __builtin_amdgcn_rcpf(d.x); t.y = __builtin_amdgcn_rcpf(d.y);
    f32x2 q = t * 0.5307027145f + (-0.7265760135f); q = q * t + 0.7107068705f; q = q * t + (-0.142248368f); q = q * t + 0.127414796f; q = q * t;
    const f32x2 s = (v * v) * (-0.72134752044f);
    f32x2 e; e.x = __builtin_amdgcn_exp2f(s.x); e.y = __builtin_amdgcn_exp2f(s.y);
    const f32x2 m = v * (q * e), r = v - m;
    f32x2 o; o.x = v.x < 0.f ? m.x : r.x; o.y = v.y < 0.f ? m.y : r.y; return o;
}
__device__ __forceinline__ float sigmoid_f(float x) { return __builtin_amdgcn_rcpf(1.0f + __expf(-x)); }
__device__ __forceinline__ float bf_lo(unsigned w) { return __uint_as_float(w << 16); }
__device__ __forceinline__ float bf_hi(unsigned w) { return __uint_as_float(w & 0xffff0000u); }

struct EpiWin {
    static constexpr bool PERM = true, AFTER_DRAIN = false;
    bf16_t* O; int ldc; int gelu_tiles; int rot_lo, rot_hi, rot_q_hi; const float* cs; const float* sn;
    __device__ __forceinline__ void operator()(const f32x4 (&acc)[2][2][4][2], const Unit& u, int wr, int wc, int fr, int fq) const {
        const int row0 = u.pm * BM + wr * 64 + fr, col0 = u.pn * BM + wc * 32 + 8 * fq;
        const bool g = u.pn < gelu_tiles, rot = (u.pn >= rot_lo) && (u.pn < rot_hi);
        const float qs = (u.pn < rot_q_hi) ? 0.0625f : 1.0f;
#pragma unroll
        for (int ai = 0; ai < 2; ++ai)
#pragma unroll
            for (int m = 0; m < 4; ++m) { const int row = row0 + ai * HALF + m * 16; bf16_t* rowp = O + (size_t)row * ldc + col0;
                f32x4 v[2][2];
#pragma unroll
                for (int bj = 0; bj < 2; ++bj) { v[bj][0] = acc[ai][bj][m][0]; v[bj][1] = acc[ai][bj][m][1]; }
                if (g) {
#pragma unroll
                    for (int bj = 0; bj < 2; ++bj)
#pragma unroll
                        for (int n = 0; n < 2; ++n) { f32x2 a = gelu_pk((f32x2){v[bj][n][0], v[bj][n][1]}), b = gelu_pk((f32x2){v[bj][n][2], v[bj][n][3]}); v[bj][n] = (f32x4){a.x, a.y, b.x, b.y}; }
                }
                if (rot) {
                    const int fi = wc * 32 + 8 * fq;
#pragma unroll
                    for (int n = 0; n < 2; ++n) { const f32x4 c4 = *(const f32x4*)(cs + (size_t)row * 128 + fi + 4 * n), s4 = *(const f32x4*)(sn + (size_t)row * 128 + fi + 4 * n);
                        const f32x4 x1 = v[0][n], x2 = v[1][n]; v[0][n] = (x1 * c4 - x2 * s4) * qs; v[1][n] = (x1 * s4 + x2 * c4) * qs; }
                }
#pragma unroll
                for (int bj = 0; bj < 2; ++bj) { u32x4 w; w.x = cvt_pk_bf16(v[bj][0][0], v[bj][0][1]); w.y = cvt_pk_bf16(v[bj][0][2], v[bj][0][3]); w.z = cvt_pk_bf16(v[bj][1][0], v[bj][1][1]); w.w = cvt_pk_bf16(v[bj][1][2], v[bj][1][3]);
                    *(u32x4*)(rowp + bj * HALF) = w; } }
    }
};
struct EpiWout {
    static constexpr bool PERM = false, AFTER_DRAIN = false;
    const float* xres; float* Z; float alpha;
    __device__ __forceinline__ void operator()(const f32x4 (&acc)[2][2][4][2], const Unit& u, int wr, int wc, int fr, int fq) const {
        const int row0 = u.pm * BM + wr * 64 + fr, col0 = u.pn * BM + wc * 32 + 4 * fq;
#pragma unroll
        for (int ai = 0; ai < 2; ++ai)
#pragma unroll
            for (int m = 0; m < 4; ++m) { const size_t off = (size_t)(row0 + ai * HALF + m * 16) * 2048 + col0;
#pragma unroll
                for (int bj = 0; bj < 2; ++bj)
#pragma unroll
                    for (int n = 0; n < 2; ++n) { const f32x4 xr = *(const f32x4*)(xres + off + bj * HALF + n * 16); *(f32x4*)(Z + off + bj * HALF + n * 16) = xr * alpha + acc[ai][bj][m][n]; } }
    }
};
struct EpiGlu {
    static constexpr bool PERM = true, AFTER_DRAIN = false;
    const bf16_t* YS; const float* bias; bf16_t* YC;
    __device__ __forceinline__ void operator()(const f32x4 (&acc)[2][2][4][2], const Unit& u, int wr, int wc, int fr, int fq) const {
        const int row0 = u.pm * BM + wr * 64 + fr, col0 = u.pn * BM + wc * 32 + 8 * fq;
        f32x4 bv[2][2];
#pragma unroll
        for (int bj = 0; bj < 2; ++bj)
#pragma unroll
            for (int n = 0; n < 2; ++n) bv[bj][n] = *(const f32x4*)(bias + col0 + bj * HALF + 4 * n);
#pragma unroll
        for (int ai = 0; ai < 2; ++ai)
#pragma unroll
            for (int m = 0; m < 4; ++m) { const int row = row0 + ai * HALF + m * 16;
#pragma unroll
                for (int bj = 0; bj < 2; ++bj) { const u32x4 yw = *(const u32x4*)(YS + (size_t)row * 1024 + col0 + bj * HALF);
                    const f32x4 a0 = acc[ai][bj][m][0] + bv[bj][0], a1 = acc[ai][bj][m][1] + bv[bj][1];
                    u32x4 w;
                    w.x = cvt_pk_bf16(bf_lo(yw.x) * sigmoid_f(a0[0]), bf_hi(yw.x) * sigmoid_f(a0[1])); w.y = cvt_pk_bf16(bf_lo(yw.y) * sigmoid_f(a0[2]), bf_hi(yw.y) * sigmoid_f(a0[3]));
                    w.z = cvt_pk_bf16(bf_lo(yw.z) * sigmoid_f(a1[0]), bf_hi(yw.z) * sigmoid_f(a1[1])); w.w = cvt_pk_bf16(bf_lo(yw.w) * sigmoid_f(a1[2]), bf_hi(yw.w) * sigmoid_f(a1[3]));
                    *(u32x4*)(YC + (size_t)row * 2048 + col0 + bj * HALF) = w; } }
    }
};
struct EpiMoe1 {
    static constexpr bool PERM = true, AFTER_DRAIN = false;
    bf16_t* ACT;
    __device__ __forceinline__ void operator()(const f32x4 (&acc)[2][2][4][2], const Unit& u, int wr, int wc, int fr, int fq) const {
        const int col0 = u.pn * HALF + wc * 32 + 8 * fq;
        bf16_t* base = ACT + ((size_t)u.e * 8192 + (size_t)u.pm * BM) * 1024 + col0;
#pragma unroll
        for (int ai = 0; ai < 2; ++ai)
#pragma unroll
            for (int m = 0; m < 4; ++m) { const int r = ai * HALF + wr * 64 + m * 16 + fr;
                if (r < u.rows) { float o[8];
#pragma unroll
                    for (int n = 0; n < 2; ++n)
#pragma unroll
                        for (int j = 0; j < 4; ++j) { const float hg = acc[ai][0][m][n][j], hu = acc[ai][1][m][n][j]; o[4 * n + j] = hg * sigmoid_f(hg) * hu; }
                    u32x4 w; w.x = cvt_pk_bf16(o[0], o[1]); w.y = cvt_pk_bf16(o[2], o[3]); w.z = cvt_pk_bf16(o[4], o[5]); w.w = cvt_pk_bf16(o[6], o[7]);
                    *(u32x4*)(base + (size_t)r * 1024) = w; } }
    }
};
struct EpiMoe2 {
    static constexpr bool PERM = true, AFTER_DRAIN = false;
    const int* dst; const float* gate; bf16_t* YB;
    __device__ __forceinline__ void operator()(const f32x4 (&acc)[2][2][4][2], const Unit& u, int wr, int wc, int fr, int fq) const {
        const int col0 = u.pn * BM + wc * 32 + 8 * fq; const size_t rb = (size_t)u.e * 8192 + (size_t)u.pm * BM;
#pragma unroll
        for (int ai = 0; ai < 2; ++ai)
#pragma unroll
            for (int m = 0; m < 4; ++m) { const int r = ai * HALF + wr * 64 + m * 16 + fr;
                if (r < u.rows) { const int d = dst[rb + r]; const float gt = gate[rb + r]; bf16_t* rowp = YB + (size_t)d * 2048 + col0;
#pragma unroll
                    for (int bj = 0; bj < 2; ++bj) { const f32x4 v0 = acc[ai][bj][m][0] * gt, v1 = acc[ai][bj][m][1] * gt;
                        u32x4 w; w.x = cvt_pk_bf16(v0[0], v0[1]); w.y = cvt_pk_bf16(v0[2], v0[3]); w.z = cvt_pk_bf16(v1[0], v1[1]); w.w = cvt_pk_bf16(v1[2], v1[3]);
                        *(u32x4*)(rowp + bj * HALF) = w; } } }
    }
};

template <class Epi, class Sched, bool ALIGN_EPI = false, bool SP2 = false>
__device__ __forceinline__ void gemm_phase(PG8_LAS unsigned char* lds, const int Kdim, const Sched& S, const Epi& E) {
    int tid_ = threadIdx.x; asm volatile("" : "+v"(tid_));
    const int tid = tid_, wid = __builtin_amdgcn_readfirstlane(tid >> 6), lane = tid & 63, wr = wid >> 2, wc = wid & 3, fr = lane & 15, fq = lane >> 4;
    const int K = Kdim, nt = K / BK;
    unsigned voffA[2], voffB[2];
#pragma unroll
    for (int i = 0; i < 2; ++i) { int R, C; stage_rc(tid * 16 + i * 8192, R, C); const int Rb = Epi::PERM ? ((R & ~31) + perm32(R & 31)) : R;
        voffA[i] = (unsigned)(R * K + C) * 2u; voffB[i] = (unsigned)(Rb * K + C) * 2u; }
    const size_t kstep = (size_t)(BK * 2);
    const size_t hstep = (size_t)HALF * K * 2;
    const unsigned ldsw = (unsigned)wid * 1024u;
    const int aoff = lds_byte(wr * 64 + fr, fq * 8), boff = lds_byte(wc * 32 + fr, fq * 8);
#define PG8_SA(b, h) (((b) * 2 + (h)) * HTB)
#define PG8_SB(b, h) ((4 + (b) * 2 + (h)) * HTB)
#define PG8_STAGE(bufoff, gbase, voff) do { _Pragma("unroll") for (int _i = 0; _i < 2; ++_i) \
        __builtin_amdgcn_global_load_lds((const unsigned*)((const char*)(gbase) + (voff)[_i]), (PG8_LAS unsigned*)(lds + (bufoff) + ldsw + _i * 8192), 16, 0, 0); } while (0)
#define PG8_LDA(dst, b, h) do { _Pragma("unroll") for (int m = 0; m < 4; ++m) _Pragma("unroll") for (int k = 0; k < 2; ++k) dst[m][k] = *(const PG8_LAS bf16x8*)(lds + PG8_SA(b, h) + aoff + m * 2048 + k * 1024); } while (0)
#define PG8_LDB(dst, b, h) do { _Pragma("unroll") for (int n = 0; n < 2; ++n) _Pragma("unroll") for (int k = 0; k < 2; ++k) dst[n][k] = *(const PG8_LAS bf16x8*)(lds + PG8_SB(b, h) + boff + n * 2048 + k * 1024); } while (0)
#define PG8_MMA(ai, bj, At, Bt) do { __builtin_amdgcn_s_setprio(1); _Pragma("unroll") for (int m = 0; m < 4; ++m) _Pragma("unroll") for (int n = 0; n < 2; ++n) _Pragma("unroll") for (int k = 0; k < 2; ++k) \
        acc[ai][bj][m][n] = __builtin_amdgcn_mfma_f32_16x16x32_bf16(Bt[n][k], At[m][k], acc[ai][bj][m][n], 0, 0, 0); __builtin_amdgcn_s_setprio(0); } while (0)
#define PG8_WAIT_V(n) asm volatile("s_waitcnt vmcnt(" #n ")" ::: "memory")
#define PG8_WAIT_L(n) asm volatile("s_waitcnt lgkmcnt(" #n ")" ::: "memory")
#define PG8_BAR __builtin_amdgcn_s_barrier()
#define PG8_SCHED __builtin_amdgcn_sched_barrier(0)
    Unit cur, nxt; int ui = 0;
    if (!S.next(0, cur)) return;
    f32x4 acc[2][2][4][2];
#pragma unroll
    for (int a = 0; a < 2; ++a)
#pragma unroll
        for (int b = 0; b < 2; ++b)
#pragma unroll
            for (int m = 0; m < 4; ++m)
#pragma unroll
                for (int n = 0; n < 2; ++n) acc[a][b][m][n] = (f32x4){0.f, 0.f, 0.f, 0.f};
    bf16x8 At[4][2], B0[2][2], B1[2][2];
    const char* cA = cur.A; const char* cB = cur.B;
    S.a_ready(cur);
    if constexpr (SP2) {
        PG8_STAGE(PG8_SB(0, 0), cB, voffB); PG8_STAGE(PG8_SB(0, 1), cB + hstep, voffB); PG8_STAGE(PG8_SA(0, 0), cA, voffA); PG8_STAGE(PG8_SA(0, 1), cA + hstep, voffA);
        if (wr == 1) PG8_BAR;
        PG8_WAIT_V(2); PG8_BAR;
        PG8_STAGE(PG8_SB(1, 0), cB + kstep, voffB); PG8_STAGE(PG8_SA(1, 0), cA + kstep, voffA); PG8_STAGE(PG8_SB(1, 1), cB + hstep + kstep, voffB);
        PG8_WAIT_V(6); PG8_BAR;
    } else {
        PG8_STAGE(PG8_SB(0, 0), cB, voffB); PG8_STAGE(PG8_SA(0, 0), cA, voffA); PG8_STAGE(PG8_SB(0, 1), cB + hstep, voffB); PG8_STAGE(PG8_SA(0, 1), cA + hstep, voffA);
        if (wr == 1) PG8_BAR;
        PG8_WAIT_V(4); PG8_BAR;
        PG8_STAGE(PG8_SB(1, 0), cB + kstep, voffB); PG8_STAGE(PG8_SA(1, 0), cA + kstep, voffA); PG8_STAGE(PG8_SB(1, 1), cB + hstep + kstep, voffB);
        PG8_WAIT_V(6); PG8_BAR;
    }
    for (;;) {
        const bool has_next = S.next(ui + 1, nxt);
        const char* nA = has_next ? nxt.A : cA; const char* nB = has_next ? nxt.B : cB;
        for (int t = 0; t < nt; t += 2) {
            const bool last = (t == nt - 2);
            const char* a1 = cA + (size_t)(t + 1) * kstep;
            const char* a2 = last ? nA : cA + (size_t)(t + 2) * kstep; const char* b2 = last ? nB : cB + (size_t)(t + 2) * kstep;
            const char* a3 = a2 + kstep; const char* b3 = b2 + kstep;
            if (last && has_next) S.a_ready(nxt);
            if constexpr (SP2) {
            PG8_LDB(B0, 0, 0); PG8_LDB(B1, 0, 1); PG8_SCHED; PG8_LDA(At, 0, 0); PG8_STAGE(PG8_SA(1, 1), a1 + hstep, voffA);
            PG8_WAIT_V(8); PG8_WAIT_L(0); PG8_BAR; PG8_MMA(0, 0, At, B0); PG8_MMA(0, 1, At, B1); PG8_BAR; PG8_SCHED;
            PG8_LDA(At, 0, 1); PG8_STAGE(PG8_SB(0, 0), b2, voffB); PG8_STAGE(PG8_SB(0, 1), b2 + hstep, voffB); PG8_STAGE(PG8_SA(0, 0), a2, voffA);
            PG8_WAIT_V(8); PG8_WAIT_L(0); PG8_BAR; PG8_MMA(1, 0, At, B0); PG8_MMA(1, 1, At, B1); PG8_BAR; PG8_SCHED;
            PG8_LDB(B0, 1, 0); PG8_LDB(B1, 1, 1); PG8_SCHED; PG8_LDA(At, 1, 0); PG8_STAGE(PG8_SA(0, 1), a2 + hstep, voffA);
            PG8_WAIT_V(8); PG8_WAIT_L(0); PG8_BAR; PG8_MMA(0, 0, At, B0); PG8_MMA(0, 1, At, B1); PG8_BAR; PG8_SCHED;
            PG8_LDA(At, 1, 1); PG8_STAGE(PG8_SB(1, 0), b3, voffB); PG8_STAGE(PG8_SB(1, 1), b3 + hstep, voffB); PG8_STAGE(PG8_SA(1, 0), a3, voffA);
            PG8_WAIT_V(8); PG8_WAIT_L(0); PG8_BAR; PG8_MMA(1, 0, At, B0); PG8_MMA(1, 1, At, B1); PG8_BAR; PG8_SCHED;
            } else {
            PG8_LDB(B0, 0, 0); PG8_SCHED; PG8_LDA(At, 0, 0); PG8_STAGE(PG8_SA(1, 1), a1 + hstep, voffA);
            PG8_WAIT_L(8); PG8_BAR; PG8_WAIT_L(0); PG8_MMA(0, 0, At, B0); PG8_BAR; PG8_SCHED;
            PG8_LDB(B1, 0, 1); PG8_STAGE(PG8_SB(0, 0), b2, voffB);
            PG8_BAR; PG8_WAIT_L(0); PG8_MMA(0, 1, At, B1); PG8_BAR;
            PG8_LDA(At, 0, 1); PG8_STAGE(PG8_SA(0, 0), a2, voffA);
            PG8_BAR; PG8_WAIT_L(0); PG8_MMA(1, 0, At, B0); PG8_BAR; PG8_SCHED;
            PG8_STAGE(PG8_SB(0, 1), b2 + hstep, voffB);
            PG8_WAIT_V(6); PG8_BAR; PG8_MMA(1, 1, At, B1); PG8_BAR;
            PG8_LDB(B0, 1, 0); PG8_SCHED; PG8_LDA(At, 1, 0); PG8_STAGE(PG8_SA(0, 1), a2 + hstep, voffA);
            PG8_WAIT_L(8); PG8_BAR; PG8_WAIT_L(0); PG8_MMA(0, 0, At, B0); PG8_BAR; PG8_SCHED;
            PG8_LDB(B1, 1, 1); PG8_STAGE(PG8_SB(1, 0), b3, voffB);
            PG8_BAR; PG8_WAIT_L(0); PG8_MMA(0, 1, At, B1); PG8_BAR;
            PG8_LDA(At, 1, 1); PG8_STAGE(PG8_SA(1, 0), a3, voffA);
            PG8_BAR; PG8_WAIT_L(0); PG8_MMA(1, 0, At, B0); PG8_BAR; PG8_SCHED;
            PG8_STAGE(PG8_SB(1, 1), b3 + hstep, voffB);
            PG8_WAIT_V(6); PG8_BAR; PG8_MMA(1, 1, At, B1); PG8_BAR;
            }
        }
        if constexpr (ALIGN_EPI) { if (wr == 0) PG8_BAR; }
        if constexpr (!Epi::AFTER_DRAIN) { E(acc, cur, wr, wc, fr, fq); S.done(cur); }
        if (!has_next) break;
#pragma unroll
        for (int a = 0; a < 2; ++a)
#pragma unroll
            for (int b = 0; b < 2; ++b)
#pragma unroll
                for (int m = 0; m < 4; ++m)
#pragma unroll
                    for (int n = 0; n < 2; ++n) acc[a][b][m][n] = (f32x4){0.f, 0.f, 0.f, 0.f};
        cur = nxt; cA = nA; cB = nB; ++ui;
        if constexpr (ALIGN_EPI) { if (wr == 1) PG8_BAR; }
    }
    PG8_WAIT_V(0);
    if constexpr (!ALIGN_EPI) { if (wr == 0) PG8_BAR; }
    PG8_BAR;
    if constexpr (Epi::AFTER_DRAIN) { E.fused(acc, cur, wr, wc, fr, fq, lds, wid, lane); S.done(cur); }
#undef PG8_SA
#undef PG8_SB
#undef PG8_STAGE
#undef PG8_LDA
#undef PG8_LDB
#undef PG8_MMA
#undef PG8_WAIT_V
#undef PG8_WAIT_L
#undef PG8_BAR
#undef PG8_SCHED
}
}

constexpr int NWAVES = 8, NTHR = 512;
constexpr int T = 8192, D = 2048, SEQ = 2048;
constexpr int HE = 6144, HO = 5376, HO_SRC = 5136;
constexpr int DEPTH = 4;
constexpr float DN_ALPHA = 1.681792830507429f;
constexpr float LN_EPS = 1e-5f, RMS_EPS = 1e-6f;

#ifndef FAST_GATE
#define FAST_GATE 0
#endif
#ifndef FAST_RET
#define FAST_RET 0
#endif
#ifndef FAST_S5
#define FAST_S5 0
#endif
#ifndef FAST_DN
#define FAST_DN 0
#endif

constexpr size_t MiB = 1ull << 20;
constexpr size_t WS_CTL = 0, CTL_BYTES = MiB;
constexpr size_t SZ_WIE = 24 * MiB, SZ_WIO = 21 * MiB, SZ_WO = 8 * MiB, SZ_WGL = 2 * MiB, SZ_MW1 = 8 * MiB, SZ_MW2 = 4 * MiB;
constexpr size_t WS_WIE = WS_CTL + CTL_BYTES;
constexpr size_t WS_WIO = WS_WIE + 2 * SZ_WIE;
constexpr size_t WS_WOE = WS_WIO + 2 * SZ_WIO;
constexpr size_t WS_WOO = WS_WOE + 2 * SZ_WO;
constexpr size_t WS_WGL = WS_WOO + 2 * SZ_WO;
constexpr size_t WS_MW1 = WS_WGL + 2 * SZ_WGL;
constexpr size_t WS_MW2 = WS_MW1 + 64 * SZ_MW1;
constexpr size_t WS_COS = WS_MW2 + 64 * SZ_MW2;
constexpr size_t WS_SIN = WS_COS + 4 * MiB;
constexpr size_t WS_XF = WS_SIN + 4 * MiB;
constexpr size_t WS_Z = WS_XF + 64 * MiB;
constexpr size_t WS_XB = WS_Z + 64 * MiB;
constexpr size_t WS_H = WS_XB + 32 * MiB;
constexpr size_t WS_YC = WS_H + 96 * MiB;
constexpr size_t WS_XS = WS_YC + 32 * MiB;
constexpr size_t WS_ACT = WS_XS + 512 * MiB;
constexpr size_t WS_YB = WS_ACT + 256 * MiB;
constexpr size_t WS_DST = WS_YB + 64 * MiB;
constexpr size_t WS_GATE = WS_DST + MiB;
constexpr size_t WS_SCR = WS_GATE + MiB;
constexpr size_t SCR_BYTES = 640 * MiB;
constexpr size_t WS_END = WS_SCR + SCR_BYTES;
constexpr size_t SC_OI = 0;
constexpr size_t SC_OS = 32 * MiB;
constexpr size_t SC_VLN = 64 * MiB;
constexpr size_t SC_QR = 96 * MiB, SC_KR = 128 * MiB;
constexpr size_t SC_SC = 160 * MiB;
constexpr size_t SC_KV = 168 * MiB;
constexpr size_t SC_YS = 0;
constexpr size_t SC_X5 = 64 * MiB;
constexpr size_t SC_QN = 320 * MiB, SC_KN = 352 * MiB, SC_VN = 384 * MiB;
constexpr size_t SC_BETA = 416 * MiB, SC_G = 417 * MiB;
constexpr size_t SC_DO = 32 * MiB;
static_assert(SC_KV + 128 * MiB <= SCR_BYTES && SC_G + MiB <= SCR_BYTES, "scratch map");
constexpr int CW_BAR = 4096;
constexpr int CW_CNT = 16384;
static_assert((CW_CNT + 64 * 64) * 4 <= (int)CTL_BYTES, "ctl");

constexpr int RING_BYTES = 131072;
constexpr int MISC_OFF = RING_BYTES;
constexpr int LDS_BYTES = 147456;

#define LAS __attribute__((address_space(3)))
#define GAS __attribute__((address_space(1)))
typedef unsigned short bf16;
typedef float f32x4 __attribute__((ext_vector_type(4)));
typedef float f32x2 __attribute__((ext_vector_type(2)));
typedef unsigned v4u __attribute__((ext_vector_type(4)));
typedef unsigned v2u __attribute__((ext_vector_type(2)));
#define LDS_WAIT() asm volatile("s_waitcnt lgkmcnt(0)" ::: "memory")
#define VM_WAIT() asm volatile("s_waitcnt vmcnt(0)" ::: "memory")
__device__ __forceinline__ unsigned f2bf(float f) { unsigned u = __builtin_bit_cast(unsigned, f); return (u + 0x7fffu + ((u >> 16) & 1u)) >> 16; }
__device__ __forceinline__ unsigned pk2(float lo, float hi) { return f2bf(lo) | (f2bf(hi) << 16); }
__device__ __forceinline__ float bf2f(bf16 b) { return __uint_as_float(((unsigned)b) << 16); }
#define DPP_XOR1 0xB1
#define DPP_XOR2 0x4E
__device__ __forceinline__ float wave_sum(float v) {
    v += __builtin_bit_cast(float, __builtin_amdgcn_mov_dpp(__builtin_bit_cast(int, v), 0xB1, 0xF, 0xF, true));
    v += __builtin_bit_cast(float, __builtin_amdgcn_mov_dpp(__builtin_bit_cast(int, v), 0x4E, 0xF, 0xF, true));
    v += __builtin_bit_cast(float, __builtin_amdgcn_mov_dpp(__builtin_bit_cast(int, v), 0x141, 0xF, 0xF, true));
    v += __builtin_bit_cast(float, __builtin_amdgcn_mov_dpp(__builtin_bit_cast(int, v), 0x140, 0xF, 0xF, true));
    v += __builtin_bit_cast(float, __builtin_amdgcn_ds_swizzle(__builtin_bit_cast(int, v), 0x401F));
    return __builtin_bit_cast(float, __builtin_amdgcn_readlane(__builtin_bit_cast(int, v), 0)) + __builtin_bit_cast(float, __builtin_amdgcn_readlane(__builtin_bit_cast(int, v), 32));
}
__device__ __forceinline__ float quad_sum(float v) {
    v += __builtin_bit_cast(float, __builtin_amdgcn_mov_dpp(__builtin_bit_cast(int, v), 0xB1, 0xF, 0xF, true));
    v += __builtin_bit_cast(float, __builtin_amdgcn_mov_dpp(__builtin_bit_cast(int, v), 0x4E, 0xF, 0xF, true));
    return v;
}
__device__ __forceinline__ float silu_f(float x) { return x / (1.0f + __expf(-x)); }

#define XB_TMO      128
#define XB_XCNT(j)  (256  + 64 * (j))
#define XB_XSUB(j)  (1280 + 64 * (j))
#define XB_XGEN(j)  (2304 + 64 * (j))
#define XB_TOP      3328
#define XB_TOPGEN   3392
#define XCD_BAR_WORDS 3456
#define XB_SPIN_CAP (1u << 22)

__device__ __forceinline__ unsigned xb_ld(unsigned* p)              { return __hip_atomic_load(p, __ATOMIC_RELAXED, __HIP_MEMORY_SCOPE_AGENT); }
__device__ __forceinline__ unsigned xb_add(unsigned* p, unsigned v) { return __hip_atomic_fetch_add(p, v, __ATOMIC_RELAXED, __HIP_MEMORY_SCOPE_AGENT); }
__device__ __forceinline__ unsigned xb_xcc_id() { return (unsigned)__builtin_amdgcn_s_getreg((3 << 11) | 20) & 0xFu; }
#define XB_SPIN(cond, bar) do { unsigned _sp = 0; while (cond) { __builtin_amdgcn_s_sleep(1); \
    if ((++_sp & 255u) == 0u) { if (xb_ld(&(bar)[XB_TMO])) break; if (_sp > XB_SPIN_CAP) { atomicAdd(&(bar)[XB_TMO], 1u); break; } } } } while (0)

struct XcdBarrier { unsigned* bar; unsigned x; volatile LAS unsigned* st; };

__device__ __forceinline__ XcdBarrier xcd_barrier_post(unsigned* bar, volatile LAS unsigned* st) {
    XcdBarrier b; b.bar = bar; b.x = xb_xcc_id(); b.st = st;
    if (threadIdx.x == 0) (void)xb_add(&bar[XB_XCNT(b.x)], 1u);
    return b;
}
__device__ __forceinline__ void xcd_barrier_complete(unsigned* bar, unsigned x, unsigned& nloc, unsigned& nx) {
    const unsigned G = gridDim.x * gridDim.y * gridDim.z;
    unsigned sum, cnt, mine, sp = 0u;
    for (;;) {
        sum = 0u; cnt = 0u; mine = 0u;
#pragma unroll
        for (unsigned j = 0; j < 16; ++j) { const unsigned c = xb_ld(&bar[XB_XCNT(j)]); sum += c; cnt += (c > 0u) ? 1u : 0u; mine = (j == x) ? c : mine; }
        if (sum == G) break;
        __builtin_amdgcn_s_sleep(1);
        if ((++sp & 255u) == 0u) { if (xb_ld(&bar[XB_TMO])) break; if (sp > XB_SPIN_CAP) { atomicAdd(&bar[XB_TMO], 1u); break; } }
    }
    nloc = mine > 0u ? mine : 1u; nx = cnt > 0u ? cnt : 1u;
}
__device__ __forceinline__ void xcd_barrier(const XcdBarrier& b) {
    asm volatile("s_waitcnt vmcnt(0)" ::: "memory");
    __syncthreads();
    if (threadIdx.x == 0) {
        unsigned* bar = b.bar; unsigned bx = b.x;
        asm volatile("" : "+s"(bar), "+s"(bx));
        __builtin_amdgcn_s_waitcnt(0);
        unsigned nloc = b.st[0], nx = b.st[1];
        if (nloc == 0u) { xcd_barrier_complete(bar, bx, nloc, nx); b.st[0] = nloc; b.st[1] = nx; }
        const unsigned old = xb_add(&bar[XB_XSUB(bx)], 1u);
        const unsigned gen = old / nloc;
        if (old + 1u == (gen + 1u) * nloc) {
            __builtin_amdgcn_fence(__ATOMIC_RELEASE, "agent");
            asm volatile("s_waitcnt vmcnt(0)" ::: "memory");
            const unsigned og = xb_add(&bar[XB_TOP], 1u);
            const unsigned tg = og / nx;
            if (og + 1u == (tg + 1u) * nx) xb_add(&bar[XB_TOPGEN], 1u);
            else XB_SPIN(xb_ld(&bar[XB_TOPGEN]) == tg, bar);
            __builtin_amdgcn_fence(__ATOMIC_ACQUIRE, "agent");
            xb_add(&bar[XB_XGEN(bx)], 1u);
            asm volatile("s_waitcnt vmcnt(0)" ::: "memory");
        } else {
            XB_SPIN(xb_ld(&bar[XB_XGEN(bx)]) == gen, bar);
            __builtin_amdgcn_fence(__ATOMIC_ACQUIRE, "agent");
            asm volatile("s_waitcnt vmcnt(0)" ::: "memory");
        }
    }
    __syncthreads();
}

struct Args { const void* in[34]; float* out; unsigned char* ws; int ph_lo, ph_hi; };
typedef __attribute__((address_space(4))) const char karg_char;
__device__ __forceinline__ const void* argp(int i) {
    karg_char* kp = (karg_char*)__builtin_amdgcn_kernarg_segment_ptr();
    asm volatile("" : "+s"(kp));
    typedef const void* gptr_t; typedef __attribute__((address_space(4))) const gptr_t karg_ptr_t;
    return *(karg_ptr_t*)(kp + 8 * i);
}
#define INF(i) ((const float*)argp(i))

struct Ctx { LAS unsigned char* lds; unsigned char* ws; int tid, lane, wave, G, gw, NGW, bid; size_t gtid, gsz; };
__device__ __forceinline__ Ctx fresh(const Ctx& C0) { Ctx C = C0; asm volatile("" : "+v"(C.tid), "+s"(C.ws), "+s"(C.bid)); C.lane = C.tid & 63; C.gw = C.bid * 8 + C.wave; C.gtid = (size_t)C.bid * 512 + C.tid; return C; }

__device__ __forceinline__ void conv_item(const float* W, int K, int Nsrc, int src_n0, bf16* WT, int dst_n0, int k0, LAS float* scr, int lane) {
    const int sc = src_n0 + (lane & 31); const bool ok = sc < Nsrc;
#pragma unroll 8
    for (int i = 0; i < 32; ++i) { const int kk = 2 * i + (lane >> 5); scr[kk * 33 + (lane & 31)] = ok ? W[(size_t)(k0 + kk) * Nsrc + sc] : 0.f; }
    LDS_WAIT(); asm volatile("" ::: "memory");
    const int c = lane & 7;
#pragma unroll
    for (int j = 0; j < 4; ++j) { const int n = (lane >> 3) + 8 * j; const LAS float* s = scr + (8 * c) * 33 + n;
        v4u o; o.x = pk2(s[0 * 33], s[1 * 33]); o.y = pk2(s[2 * 33], s[3 * 33]); o.z = pk2(s[4 * 33], s[5 * 33]); o.w = pk2(s[6 * 33], s[7 * 33]);
        *(v4u*)(WT + (size_t)(dst_n0 + n) * K + k0 + 8 * c) = o; }
    LDS_WAIT(); asm volatile("" ::: "memory");
}
__device__ __forceinline__ void conv_matrix(const Ctx& C, const float* W, int K, int Nsrc, int Ndst, bf16* WT, int map) {
    LAS float* scr = (LAS float*)(C.lds + C.wave * 8448);
    const int nblk = Ndst / 32, items = (K / 64) * nblk;
    for (int it = C.gw; it < items; it += C.NGW) {
        const int kb = it / nblk, nb = it % nblk, n0 = 32 * nb;
        int s0 = n0;
        if (map == 1) { const int tile = n0 >> 8, within = n0 & 255; s0 = (within < 128) ? (128 * tile + within) : (1024 + 128 * tile + within - 128); }
        conv_item(W, K, Nsrc, s0, WT, n0, 64 * kb, scr, C.lane);
    }
}
__device__ __forceinline__ void phase_prologue(const Args& args, const Ctx& C0) {
    const Ctx C = fresh(C0);
    unsigned char* ws = C.ws;
    for (int i = 0; i < 2; ++i) {
        conv_matrix(C, INF(10) + (size_t)i * 2048 * 6144, 2048, 6144, 6144, (bf16*)(ws + WS_WIE + i * SZ_WIE), 0);
        conv_matrix(C, INF(18) + (size_t)i * 2048 * HO_SRC, 2048, HO_SRC, HO, (bf16*)(ws + WS_WIO + i * SZ_WIO), 0);
        conv_matrix(C, INF(11) + (size_t)i * 2048 * 2048, 2048, 2048, 2048, (bf16*)(ws + WS_WOE + i * SZ_WO), 0);
        conv_matrix(C, INF(19) + (size_t)i * 2048 * 2048, 2048, 2048, 2048, (bf16*)(ws + WS_WOO + i * SZ_WO), 0);
        conv_matrix(C, INF(28) + (size_t)i * 1024 * 1024, 1024, 1024, 1024, (bf16*)(ws + WS_WGL + i * SZ_WGL), 0);
    }
    for (int le = 0; le < 64; ++le) {
        conv_matrix(C, INF(8) + (size_t)le * 2048 * 2048, 2048, 2048, 2048, (bf16*)(ws + WS_MW1 + le * SZ_MW1), 1);
        conv_matrix(C, INF(9) + (size_t)le * 1024 * 2048, 1024, 2048, 2048, (bf16*)(ws + WS_MW2 + le * SZ_MW2), 0);
    }
    const int* pos = (const int*)argp(1); float* cs = (float*)(ws + WS_COS); float* sn = (float*)(ws + WS_SIN);
    for (size_t i = C.gtid; i < (size_t)T * 128; i += C.gsz) { const int tok = (int)(i >> 7), f = (int)(i & 127);
        const float inv = powf(10000.0f, -(float)f / 128.0f); const float ang = (float)pos[tok] * inv; cs[i] = cosf(ang); sn[i] = sinf(ang); }
    const float* x = INF(0); bf16* XB = (bf16*)(ws + WS_XB);
    for (size_t i = C.gtid; i < (size_t)T * D / 4; i += C.gsz) { const f32x4 v = *(const f32x4*)(x + 4 * i); v2u o; o.x = pk2(v.x, v.y); o.y = pk2(v.z, v.w); *(v2u*)(XB + 4 * i) = o; }
}

__device__ __forceinline__ void ln_row(f32x4 (&v)[8], const float* g, const float* b, int lane) {
    float s = 0.f;
#pragma unroll
    for (int j = 0; j < 8; ++j) s += (v[j].x + v[j].y) + (v[j].z + v[j].w);
    const float mean = wave_sum(s) * (1.f / 2048.f); float s2 = 0.f;
#pragma unroll
    for (int j = 0; j < 8; ++j) { v[j] = v[j] - mean; s2 += (v[j].x * v[j].x + v[j].y * v[j].y) + (v[j].z * v[j].z + v[j].w * v[j].w); }
    const float rstd = 1.0f / sqrtf(wave_sum(s2) * (1.f / 2048.f) + LN_EPS);
#pragma unroll
    for (int j = 0; j < 8; ++j) { const f32x4 gg = *(const f32x4*)(g + 4 * lane + 256 * j), bb = *(const f32x4*)(b + 4 * lane + 256 * j); v[j] = v[j] * rstd * gg + bb; }
}
__device__ __forceinline__ void phase_ln_route(const Args& args, const Ctx& C0, int layer) {
    const Ctx C = fresh(C0);
    unsigned char* ws = C.ws;
    const float* Z = (const float*)(ws + WS_Z); float* XF = (float*)(ws + WS_XF); bf16* XS = (bf16*)(ws + WS_XS);
    int* DST = (int*)(ws + WS_DST); float* GATE = (float*)(ws + WS_GATE); unsigned* cnt = (unsigned*)(ws + WS_CTL) + CW_CNT + layer * 16 * 64;
    const float* g = INF(4) + layer * 2048; const float* b = INF(5) + layer * 2048; const float* wr = INF(2); const float* rb = INF(3);
    const int lane = C.lane;
    for (int row = C.gw; row < T; row += C.NGW) {
        f32x4 v[8];
#pragma unroll
        for (int j = 0; j < 8; ++j) v[j] = *(const f32x4*)(Z + (size_t)row * 2048 + 4 * lane + 256 * j);
        ln_row(v, g, b, lane);
#pragma unroll
        for (int j = 0; j < 8; ++j) *(f32x4*)(XF + (size_t)row * 2048 + 4 * lane + 256 * j) = v[j];
        float lg[16];
#pragma unroll
        for (int e = 0; e < 16; ++e) lg[e] = 0.f;
#pragma unroll
        for (int j = 0; j < 8; ++j)
#pragma unroll
            for (int q = 0; q < 4; ++q) { const float xv = v[j][q]; const float* wrow = wr + (size_t)(4 * lane + 256 * j + q) * 16;
#pragma unroll
                for (int e4 = 0; e4 < 4; ++e4) { const f32x4 w4 = *(const f32x4*)(wrow + 4 * e4); lg[4 * e4 + 0] += xv * w4.x; lg[4 * e4 + 1] += xv * w4.y; lg[4 * e4 + 2] += xv * w4.z; lg[4 * e4 + 3] += xv * w4.w; } }
#pragma unroll
        for (int e = 0; e < 16; ++e) lg[e] = wave_sum(lg[e]);
        float mx = lg[0];
#pragma unroll
        for (int e = 1; e < 16; ++e) mx = fmaxf(mx, lg[e]);
        float pr[16], sum = 0.f;
#pragma unroll
        for (int e = 0; e < 16; ++e) { pr[e] = expf(lg[e] - mx); sum += pr[e]; }
        const float rs = 1.0f / sum;
        float sel[16];
#pragma unroll
        for (int e = 0; e < 16; ++e) { pr[e] *= rs; sel[e] = pr[e] + rb[e]; }
        int grp = 0; float best = -3.0e38f;
#pragma unroll
        for (int gi = 0; gi < 4; ++gi) { const float a0 = sel[4 * gi], a1 = sel[4 * gi + 1], a2 = sel[4 * gi + 2], a3 = sel[4 * gi + 3];
            const float tot = (a0 + a1) + (a2 + a3), mn1 = fminf(fminf(a0, a1), fminf(a2, a3));
            const float h01 = fmaxf(a0, a1), l01 = fminf(a0, a1), h23 = fmaxf(a2, a3), l23 = fminf(a2, a3);
            const float top1 = fmaxf(h01, h23), top2 = fmaxf(fminf(h01, h23), fmaxf(l01, l23));
            (void)tot; (void)mn1;
            const float sc = top1 + top2; if (sc > best) { best = sc; grp = gi; } }
        float s4[4], p4[4];
#pragma unroll
        for (int k = 0; k < 4; ++k) { s4[k] = 0.f; p4[k] = 0.f; }
#pragma unroll
        for (int gi = 0; gi < 4; ++gi)
#pragma unroll
            for (int k = 0; k < 4; ++k) { s4[k] = (gi == grp) ? sel[4 * gi + k] : s4[k]; p4[k] = (gi == grp) ? pr[4 * gi + k] : p4[k]; }
        int i1 = 0; float b1 = s4[0];
#pragma unroll
        for (int k = 1; k < 4; ++k) if (s4[k] > b1) { b1 = s4[k]; i1 = k; }
        int i2 = -1; float b2 = -3.0e38f;
#pragma unroll
        for (int k = 0; k < 4; ++k) if (k != i1 && s4[k] > b2) { b2 = s4[k]; i2 = k; }
        float g1 = 0.f, g2 = 0.f;
#pragma unroll
        for (int k = 0; k < 4; ++k) { g1 = (k == i1) ? p4[k] : g1; g2 = (k == i2) ? p4[k] : g2; }
        const float gs = 1.0f / (g1 + g2); g1 *= gs; g2 *= gs;
        const int e1 = grp * 4 + i1, e2 = grp * 4 + i2;
        unsigned p1 = 0, p2 = 0;
        if (lane == 0) { p1 = __hip_atomic_fetch_add(cnt + e1 * 64, 1u, __ATOMIC_RELAXED, __HIP_MEMORY_SCOPE_AGENT); p2 = __hip_atomic_fetch_add(cnt + e2 * 64, 1u, __ATOMIC_RELAXED, __HIP_MEMORY_SCOPE_AGENT); }
        p1 = __builtin_amdgcn_readfirstlane(p1); p2 = __builtin_amdgcn_readfirstlane(p2);
        const size_t r1 = (size_t)e1 * 8192 + p1, r2 = (size_t)e2 * 8192 + p2;
        if (lane == 0) { DST[r1] = row * 2; DST[r2] = row * 2 + 1; GATE[r1] = g1; GATE[r2] = g2; }
#pragma unroll
        for (int j = 0; j < 8; ++j) { v2u o; o.x = pk2(v[j].x, v[j].y); o.y = pk2(v[j].z, v[j].w);
            *(v2u*)(XS + r1 * 2048 + 4 * lane + 256 * j) = o; *(v2u*)(XS + r2 * 2048 + 4 * lane + 256 * j) = o; }
    }
}
__device__ __forceinline__ void phase_ln_ffn(const Args& args, const Ctx& C0, int layer) {
    const Ctx C = fresh(C0);
    unsigned char* ws = C.ws;
    float* XF = (float*)(ws + WS_XF); const bf16* YB = (const bf16*)(ws + WS_YB); bf16* XB = (bf16*)(ws + WS_XB);
    const float* g = INF(6) + layer * 2048; const float* b = INF(7) + layer * 2048; const int lane = C.lane;
    for (int row = C.gw; row < T; row += C.NGW) {
        f32x4 v[8];
#pragma unroll
        for (int j = 0; j < 8; ++j) { const size_t c = 4 * lane + 256 * j; const f32x4 xv = *(const f32x4*)(XF + (size_t)row * 2048 + c);
            const v2u y0 = *(const v2u*)(YB + (size_t)(2 * row) * 2048 + c), y1 = *(const v2u*)(YB + (size_t)(2 * row + 1) * 2048 + c);
            f32x4 m; m.x = pg8::bf_lo(y0.x) + pg8::bf_lo(y1.x); m.y = pg8::bf_hi(y0.x) + pg8::bf_hi(y1.x); m.z = pg8::bf_lo(y0.y) + pg8::bf_lo(y1.y); m.w = pg8::bf_hi(y0.y) + pg8::bf_hi(y1.y);
            v[j] = xv * DN_ALPHA + m; }
        ln_row(v, g, b, lane);
#pragma unroll
        for (int j = 0; j < 8; ++j) { const size_t c = 4 * lane + 256 * j; *(f32x4*)(XF + (size_t)row * 2048 + c) = v[j];
            v2u o; o.x = pk2(v[j].x, v[j].y); o.y = pk2(v[j].z, v[j].w); *(v2u*)(XB + (size_t)row * 2048 + c) = o;
            if (layer == DEPTH - 1) *(f32x4*)(args.out + (size_t)row * 2048 + c) = v[j]; }
    }
}

__device__ __forceinline__ float ret_log_gamma(int h) { return log1pf(-exp2f(-5.0f - (float)h)); }
__device__ __forceinline__ void nv_even_prep(const Args& args, const Ctx& C0, int li) {
    const Ctx C = fresh(C0);
    unsigned char* ws = C.ws; const bf16* H = (const bf16*)(ws + WS_H);
    float* VLN = (float*)(ws + WS_SCR + SC_VLN); float* QR = (float*)(ws + WS_SCR + SC_QR); float* KR = (float*)(ws + WS_SCR + SC_KR);
    const float* lg = INF(12) + li * 1024; const float* lb = INF(13) + li * 1024; const float* cs = (const float*)(ws + WS_COS); const float* sn = (const float*)(ws + WS_SIN);
    for (int it = C.gw; it < T * 4; it += C.NGW) { const int tok = it >> 2, g = it & 3; const int c0 = g * 256 + 4 * C.lane;
        const v2u w = *(const v2u*)(H + (size_t)tok * HE + 1024 + c0);
        f32x4 v; v.x = pg8::bf_lo(w.x); v.y = pg8::bf_hi(w.x); v.z = pg8::bf_lo(w.y); v.w = pg8::bf_hi(w.y);
        const float mean = wave_sum((v.x + v.y) + (v.z + v.w)) * (1.f / 256.f); v = v - mean;
        const float rstd = 1.0f / sqrtf(wave_sum((v.x * v.x + v.y * v.y) + (v.z * v.z + v.w * v.w)) * (1.f / 256.f) + LN_EPS);
        *(f32x4*)(VLN + (size_t)tok * 1024 + c0) = v * rstd * *(const f32x4*)(lg + c0) + *(const f32x4*)(lb + c0); }
    for (size_t i = C.gtid; i < (size_t)T * 512; i += C.gsz) { const int tok = (int)(i >> 9), h = (int)((i >> 7) & 3), f = (int)(i & 127);
        const float c = cs[(size_t)tok * 128 + f], s = sn[(size_t)tok * 128 + f]; const bf16* base = H + (size_t)tok * HE;
        const float q1 = bf2f(base[2048 + h * 256 + f]), q2 = bf2f(base[2048 + h * 256 + 128 + f]), k1 = bf2f(base[3072 + h * 256 + f]), k2 = bf2f(base[3072 + h * 256 + 128 + f]);
        QR[(size_t)tok * 1024 + h * 256 + f] = (q1 * c - q2 * s) * 0.0625f; QR[(size_t)tok * 1024 + h * 256 + 128 + f] = (q1 * s + q2 * c) * 0.0625f;
        KR[(size_t)tok * 1024 + h * 256 + f] = k1 * c - k2 * s; KR[(size_t)tok * 1024 + h * 256 + 128 + f] = k1 * s + k2 * c; }
}
__device__ __forceinline__ void nv_even_a(const Args& args, const Ctx& C0, int li) {
    const Ctx C = fresh(C0);
    unsigned char* ws = C.ws; const bf16* H = (const bf16*)(ws + WS_H); bf16* YC = (bf16*)(ws + WS_YC);
    const float* VLN = (const float*)(ws + WS_SCR + SC_VLN); const float* QR = (const float*)(ws + WS_SCR + SC_QR); const float* KR = (const float*)(ws + WS_SCR + SC_KR);
    float* SC = (float*)(ws + WS_SCR + SC_SC); float* KV = (float*)(ws + WS_SCR + SC_KV);
    const float* Wsp = INF(14) + (size_t)li * 4 * 128 * 128; const float* Bsp = INF(15) + li * 4 * 128;
    for (size_t i = C.gtid; i < (size_t)T * 1024; i += C.gsz) { const int tok = (int)(i >> 10), c = (int)(i & 1023), g = c >> 8, ii = tok & 127, blk = tok & ~127;
        const float* wrow = Wsp + ((size_t)g * 128 + ii) * 128; const int jend = (ii >= 64) ? 128 : 64; float s = 0.f;
        for (int j = 0; j < jend; ++j) s += wrow[j] * VLN[(size_t)(blk + j) * 1024 + c];
        s += Bsp[g * 128 + ii];
        YC[(size_t)tok * 2048 + c] = (bf16)f2bf(bf2f(H[(size_t)tok * HE + c]) * s); }
    for (size_t i = C.gtid; i < (size_t)512 * 4096; i += C.gsz) { const int ch = (int)(i >> 12), ii = (int)((i >> 6) & 63), jj = (int)(i & 63), n = ch & 31, h = (ch >> 5) & 3, b = ch >> 7;
        const float* q = QR + (size_t)(b * 2048 + n * 64 + ii) * 1024 + h * 256; const float* k = KR + (size_t)(b * 2048 + n * 64 + jj) * 1024 + h * 256; float s = 0.f;
        for (int d = 0; d < 256; ++d) s += q[d] * k[d];
        const int dd = ii > jj ? ii - jj : jj - ii; SC[i] = s * expf(ret_log_gamma(h) * (float)dd); }
    for (size_t i = C.gtid; i < (size_t)512 * 65536; i += C.gsz) { const int ch = (int)(i >> 16), d = (int)((i >> 8) & 255), e = (int)(i & 255), n = ch & 31, h = (ch >> 5) & 3, b = ch >> 7;
        const float lgm = ret_log_gamma(h); const size_t t0 = (size_t)b * 2048 + n * 64; float s = 0.f;
        for (int j = 0; j < 64; ++j) s += KR[(t0 + j) * 1024 + h * 256 + d] * expf(lgm * (float)(63 - j)) * bf2f(H[(t0 + j) * HE + 4096 + h * 256 + e]);
        KV[i] = s; }
}
__device__ __forceinline__ void nv_even_b(const Args& args, const Ctx& C0) {
    const Ctx C = fresh(C0);
    unsigned char* ws = C.ws; const bf16* H = (const bf16*)(ws + WS_H);
    const float* SC = (const float*)(ws + WS_SCR + SC_SC); float* KV = (float*)(ws + WS_SCR + SC_KV); float* OI = (float*)(ws + WS_SCR + SC_OI);
    for (size_t i = C.gtid; i < (size_t)T * 1024; i += C.gsz) { const int tok = (int)(i >> 10), c = (int)(i & 1023), h = c >> 8, b = tok >> 11, n = (tok >> 6) & 31, ii = tok & 63;
        const int ch = (b * 4 + h) * 32 + n; const float* srow = SC + ((size_t)ch * 64 + ii) * 64; const size_t t0 = (size_t)(tok & ~63); float s = 0.f;
        for (int j = 0; j < 64; ++j) s += srow[j] * bf2f(H[(t0 + j) * HE + 4096 + c]);
        OI[i] = s; }
    for (size_t i = C.gtid; i < (size_t)16 * 65536; i += C.gsz) { const int bh = (int)(i >> 16), de = (int)(i & 65535), h = bh & 3;
        const float cd = expf(ret_log_gamma(h) * 64.0f); float st = 0.f;
        for (int n = 0; n < 32; ++n) { float* p = KV + ((size_t)(bh * 32 + n) << 16) + de; const float t = *p; *p = st; st = st * cd + t; } }
}
__device__ __forceinline__ void nv_even_c(const Args& args, const Ctx& C0) {
    const Ctx C = fresh(C0);
    unsigned char* ws = C.ws; const float* QR = (const float*)(ws + WS_SCR + SC_QR); const float* KV = (const float*)(ws + WS_SCR + SC_KV); float* OS = (float*)(ws + WS_SCR + SC_OS);
    for (size_t i = C.gtid; i < (size_t)T * 1024; i += C.gsz) { const int tok = (int)(i >> 10), c = (int)(i & 1023), h = c >> 8, e = c & 255, b = tok >> 11, n = (tok >> 6) & 31, ii = tok & 63;
        const int ch = (b * 4 + h) * 32 + n; const float* q = QR + (size_t)tok * 1024 + h * 256; const float* st = KV + ((size_t)ch << 16) + e; float s = 0.f;
        for (int d = 0; d < 256; ++d) s += q[d] * st[(size_t)d * 256];
        OS[i] = s * expf(ret_log_gamma(h) * (float)(ii + 1)); }
}
__device__ __forceinline__ void phase_even_normgate(const Args& args, const Ctx& C0, int li) {
    const Ctx C = fresh(C0);
    unsigned char* ws = C.ws; const bf16* H = (const bf16*)(ws + WS_H); bf16* YC = (bf16*)(ws + WS_YC);
    const float* OI = (const float*)(ws + WS_SCR + SC_OI); const float* OS = (const float*)(ws + WS_SCR + SC_OS);
    const float* gg = INF(16) + li * 1024; const float* gb = INF(17) + li * 1024;
    for (int it = C.gw; it < T * 4; it += C.NGW) { const int tok = it >> 2, h = it & 3; const int c0 = h * 256 + 4 * C.lane;
        f32x4 v = *(const f32x4*)(OI + (size_t)tok * 1024 + c0) + *(const f32x4*)(OS + (size_t)tok * 1024 + c0);
        const float mean = wave_sum((v.x + v.y) + (v.z + v.w)) * (1.f / 256.f); v = v - mean;
        const float rstd = 1.0f / sqrtf(wave_sum((v.x * v.x + v.y * v.y) + (v.z * v.z + v.w * v.w)) * (1.f / 256.f) + LN_EPS);
        v = v * rstd * *(const f32x4*)(gg + c0) + *(const f32x4*)(gb + c0);
        const v2u gw = *(const v2u*)(H + (size_t)tok * HE + 5120 + c0);
        v2u o; o.x = pk2(silu_f(pg8::bf_lo(gw.x)) * v.x, silu_f(pg8::bf_hi(gw.x)) * v.y); o.y = pk2(silu_f(pg8::bf_lo(gw.y)) * v.z, silu_f(pg8::bf_hi(gw.y)) * v.w);
        *(v2u*)(YC + (size_t)tok * 2048 + 1024 + c0) = o; }
}

__device__ __forceinline__ void nv_odd_a(const Args& args, const Ctx& C0, int li) {
    const Ctx C = fresh(C0);
    unsigned char* ws = C.ws; const bf16* H = (const bf16*)(ws + WS_H); f32x2* X5 = (f32x2*)(ws + WS_SCR + SC_X5);
    const int lane = C.lane;
    for (int it = C.gw; it < 256; it += C.NGW) { const int b = it >> 6, g = it & 63; const int gp = (li * 64 + g) * 64 + lane;
        const float dt = expf(INF(27)[li * 64 + g]), are = INF(20)[gp], aim = INF(21)[gp]; const float* pbre = INF(22); const float* pbim = INF(23);
        const float mag = expf(are * dt), lbr = mag * cosf(aim * dt), lbi = mag * sinf(aim * dt), den = are * are + aim * aim;
        const float fre = ((lbr - 1.0f) * are + lbi * aim) / den, fim = (lbi * are - (lbr - 1.0f) * aim) / den;
        float bbr[16], bbi[16];
#pragma unroll
        for (int c = 0; c < 16; ++c) { const float br = pbre[(size_t)gp * 16 + c], bi = pbim[(size_t)gp * 16 + c]; bbr[c] = fre * br - fim * bi; bbi[c] = fre * bi + fim * br; }
        float xr = 0.f, xi = 0.f;
        for (int t = 0; t < SEQ; ++t) { const size_t tok = (size_t)b * 2048 + t; const v4u u0 = *(const v4u*)(H + tok * HO + g * 16), u1 = *(const v4u*)(H + tok * HO + g * 16 + 8);
            float u[16]; u[0] = pg8::bf_lo(u0.x); u[1] = pg8::bf_hi(u0.x); u[2] = pg8::bf_lo(u0.y); u[3] = pg8::bf_hi(u0.y); u[4] = pg8::bf_lo(u0.z); u[5] = pg8::bf_hi(u0.z); u[6] = pg8::bf_lo(u0.w); u[7] = pg8::bf_hi(u0.w);
            u[8] = pg8::bf_lo(u1.x); u[9] = pg8::bf_hi(u1.x); u[10] = pg8::bf_lo(u1.y); u[11] = pg8::bf_hi(u1.y); u[12] = pg8::bf_lo(u1.z); u[13] = pg8::bf_hi(u1.z); u[14] = pg8::bf_lo(u1.w); u[15] = pg8::bf_hi(u1.w);
            float br = 0.f, bi = 0.f;
#pragma unroll
            for (int c = 0; c < 16; ++c) { br += bbr[c] * u[c]; bi += bbi[c] * u[c]; }
            const float nr = lbr * xr - lbi * xi + br, ni = lbr * xi + lbi * xr + bi; xr = nr; xi = ni;
            X5[(tok * 64 + g) * 64 + lane] = (f32x2){xr, xi}; } }
    float* QN = (float*)(ws + WS_SCR + SC_QN); float* KN = (float*)(ws + WS_SCR + SC_KN); float* VN = (float*)(ws + WS_SCR + SC_VN);
    float* BETA = (float*)(ws + WS_SCR + SC_BETA); float* GG = (float*)(ws + WS_SCR + SC_G);
    const float* cw = INF(30) + (size_t)li * 4 * 3072; const float* pdtb = INF(32); const float* palog = INF(31);
    for (int it = C.gw; it < T * 8; it += C.NGW) { const int tok = it >> 3, h = it & 7, tp = tok & 2047; float val[3][2];
#pragma unroll
        for (int s = 0; s < 3; ++s) { const int ch = s * 1024 + h * 128 + 2 * lane; float a0 = 0.f, a1 = 0.f;
#pragma unroll
            for (int k = 0; k < 4; ++k) { const int tt = tp - 3 + k; if (tt >= 0) { const unsigned w = *(const unsigned*)(H + (size_t)(tok - 3 + k) * HO + 1024 + ch); a0 += cw[k * 3072 + ch] * pg8::bf_lo(w); a1 += cw[k * 3072 + ch + 1] * pg8::bf_hi(w); } }
            val[s][0] = silu_f(a0); val[s][1] = silu_f(a1); }
        const float qn = 1.0f / sqrtf(wave_sum(val[0][0] * val[0][0] + val[0][1] * val[0][1]) + RMS_EPS) * 0.08838834764831845f;
        const float kn = 1.0f / sqrtf(wave_sum(val[1][0] * val[1][0] + val[1][1] * val[1][1]) + RMS_EPS);
        const size_t o = (size_t)tok * 1024 + h * 128 + 2 * lane;
        *(f32x2*)(QN + o) = (f32x2){val[0][0] * qn, val[0][1] * qn}; *(f32x2*)(KN + o) = (f32x2){val[1][0] * kn, val[1][1] * kn}; *(f32x2*)(VN + o) = (f32x2){val[2][0], val[2][1]};
        if (lane == 0) { const float braw = bf2f(H[(size_t)tok * HO + 5120 + h]), araw = bf2f(H[(size_t)tok * HO + 5128 + h]);
            BETA[tok * 8 + h] = 1.0f / (1.0f + expf(-braw));
            const float z = araw + pdtb[li * 8 + h]; const float sp = (z > 20.f) ? z : log1pf(expf(z));
            GG[tok * 8 + h] = -expf(palog[li * 8 + h]) * sp; } }
}
__device__ __forceinline__ void nv_odd_b(const Args& args, const Ctx& C0, int li) {
    const Ctx C = fresh(C0);
    unsigned char* ws = C.ws; const bf16* H = (const bf16*)(ws + WS_H); const f32x2* X5 = (const f32x2*)(ws + WS_SCR + SC_X5); bf16* YS = (bf16*)(ws + WS_SCR + SC_YS);
    const float* QN = (const float*)(ws + WS_SCR + SC_QN); const float* KN = (const float*)(ws + WS_SCR + SC_KN); const float* VN = (const float*)(ws + WS_SCR + SC_VN);
    const float* BETA = (const float*)(ws + WS_SCR + SC_BETA); const float* GG = (const float*)(ws + WS_SCR + SC_G); float* DOo = (float*)(ws + WS_SCR + SC_DO);
    if (C.bid < 32) { const int bh = C.bid, b = bh >> 3, h = bh & 7, e = C.tid >> 2, dq = C.tid & 3;
        float S[32];
#pragma unroll
        for (int d = 0; d < 32; ++d) S[d] = 0.f;
        for (int t = 0; t < SEQ; ++t) { const size_t tok = (size_t)b * 2048 + t; const float* k = KN + tok * 1024 + h * 128 + dq * 32; const float* q = QN + tok * 1024 + h * 128 + dq * 32;
            const float a = expf(GG[tok * 8 + h]), bt = BETA[tok * 8 + h], ve = VN[tok * 1024 + h * 128 + e];
            f32x4 kk[8];
#pragma unroll
            for (int d4 = 0; d4 < 8; ++d4) kk[d4] = *(const f32x4*)(k + 4 * d4);
            float dot = 0.f;
#pragma unroll
            for (int d4 = 0; d4 < 8; ++d4) dot += kk[d4].x * S[4 * d4] + kk[d4].y * S[4 * d4 + 1] + kk[d4].z * S[4 * d4 + 2] + kk[d4].w * S[4 * d4 + 3];
            dot = quad_sum(dot);
            const float c2 = bt * (ve - a * dot); float o = 0.f;
#pragma unroll
            for (int d4 = 0; d4 < 8; ++d4) { const f32x4 qq = *(const f32x4*)(q + 4 * d4);
                S[4 * d4] = a * S[4 * d4] + kk[d4].x * c2; S[4 * d4 + 1] = a * S[4 * d4 + 1] + kk[d4].y * c2; S[4 * d4 + 2] = a * S[4 * d4 + 2] + kk[d4].z * c2; S[4 * d4 + 3] = a * S[4 * d4 + 3] + kk[d4].w * c2;
                o += qq.x * S[4 * d4] + qq.y * S[4 * d4 + 1] + qq.z * S[4 * d4 + 2] + qq.w * S[4 * d4 + 3]; }
            o = quad_sum(o);
            if (dq == 0) DOo[tok * 1024 + h * 128 + e] = o; } }
    else { const size_t g0 = (size_t)(C.bid - 32) * NTHR + C.tid, gs = (size_t)(C.G - 32) * NTHR;
        const float* pcr = INF(24); const float* pci = INF(25); const float* pcd = INF(26);
        for (size_t i = g0; i < (size_t)T * 1024; i += gs) { const int tok = (int)(i >> 10), c = (int)(i & 1023), g = c >> 4, cc = c & 15;
            const f32x2* x = X5 + ((size_t)tok * 64 + g) * 64; const float* cr = pcr + ((size_t)(li * 64 + g) * 16 + cc) * 64; const float* ci = pci + ((size_t)(li * 64 + g) * 16 + cc) * 64; float s = 0.f;
            for (int p = 0; p < 64; ++p) { const f32x2 xv = x[p]; s += xv.x * cr[p] - xv.y * ci[p]; }
            s += pcd[(li * 64 + g) * 16 + cc] * bf2f(H[(size_t)tok * HO + c]);
            YS[i] = (bf16)f2bf(0.5f * s * (1.0f + erff(s * 0.70710678118654752f))); } }
}
__device__ __forceinline__ void phase_odd_normgate(const Args& args, const Ctx& C0, int li) {
    const Ctx C = fresh(C0);
    unsigned char* ws = C.ws; const bf16* H = (const bf16*)(ws + WS_H); bf16* YC = (bf16*)(ws + WS_YC); const float* DOo = (const float*)(ws + WS_SCR + SC_DO);
    const float* ng = INF(33) + li * 128;
    for (int it = C.gw; it < T * 8; it += C.NGW) { const int tok = it >> 3, h = it & 7; const int c0 = h * 128 + 2 * C.lane;
        const f32x2 v = *(const f32x2*)(DOo + (size_t)tok * 1024 + c0);
        const float r = 1.0f / sqrtf(wave_sum(v.x * v.x + v.y * v.y) * (1.f / 128.f) + RMS_EPS);
        const unsigned gw = *(const unsigned*)(H + (size_t)tok * HO + 4096 + c0);
        *(unsigned*)(YC + (size_t)tok * 2048 + 1024 + c0) = pk2(v.x * r * ng[2 * C.lane] * silu_f(pg8::bf_lo(gw)), v.y * r * ng[2 * C.lane + 1] * silu_f(pg8::bf_hi(gw))); }
}

__host__ __device__ constexpr bool slot_active(int layer, int slot) {
    const bool odd = layer & 1;
    if (slot == 0 || (slot >= 9 && slot <= 14)) return true;
    if (!odd) return slot >= 1 && slot <= 4;
    return slot >= 1 && slot <= 2;
}
constexpr int PH_END = 1 + 16 * DEPTH;
#ifdef TEST_SITE
#define SITE_ON(n) (TEST_SITE == (n))
#else
#define SITE_ON(n) 1
#endif

__global__ void __launch_bounds__(NTHR, 2) trunk_fwd(Args args) {
    extern __shared__ __attribute__((aligned(16))) unsigned char lds_raw[];
    Ctx C;
    C.lds = (LAS unsigned char*)lds_raw; C.tid = threadIdx.x; C.lane = C.tid & 63; C.wave = __builtin_amdgcn_readfirstlane(C.tid >> 6); C.G = gridDim.x;
    C.bid = blockIdx.x; C.gw = blockIdx.x * NWAVES + C.wave; C.NGW = C.G * NWAVES; C.gtid = (size_t)blockIdx.x * NTHR + C.tid; C.gsz = (size_t)C.G * NTHR;
    volatile LAS unsigned* MISC = (volatile LAS unsigned*)(C.lds + MISC_OFF);
    if (C.tid < 64) MISC[C.tid] = 0u;
    __syncthreads();
    C.ws = args.ws;
    unsigned* ctl = (unsigned*)(args.ws + WS_CTL);
    const int lo = args.ph_lo, hi = args.ph_hi; const bool fused = (hi - lo) > 1;
    XcdBarrier bar; bar.bar = ctl + CW_BAR; bar.x = 0; bar.st = nullptr;
    if (fused) bar = xcd_barrier_post(ctl + CW_BAR, MISC);
#define RUN(k) (lo <= (k) && (k) < hi)
#define SEAM(k) do { if (fused && (k) + 1 < PH_END - 1) xcd_barrier(bar); } while (0)

    #if SITE_ON(0)
        if (RUN(0)) { phase_prologue(args, C); __syncthreads(); SEAM(0); }
#endif


    for (int layer = 0; layer < DEPTH; ++layer) {
        const int base = 1 + 16 * layer, li = layer >> 1; const bool odd = layer & 1;
#define WSL(name) unsigned char* name = args.ws; asm volatile("" : "+s"(name))
        #if SITE_ON(1)
        if (RUN(base + 0)) { WSL(ws);
            pg8::StaticOrder S; S.init(ws + WS_XB, odd ? (ws + WS_WIO + li * SZ_WIO) : (ws + WS_WIE + li * SZ_WIE), 2048, 32, odd ? 21 : 24, C.G, (int)blockIdx.x);
            pg8::EpiWin E{(bf16*)(ws + WS_H), odd ? HO : HE, odd ? 0 : 8, 0, (!odd && FAST_RET) ? 16 : 0, 12, (const float*)(ws + WS_COS), (const float*)(ws + WS_SIN)};
            if (!odd && FAST_RET) E.rot_lo = 8;
            pg8::gemm_phase<pg8::EpiWin, pg8::StaticOrder, true, true>(C.lds, 2048, S, E);
            SEAM(base + 0);
        }
#endif

        if (!odd) {
            #if SITE_ON(2)
        if (RUN(base + 1)) { nv_even_prep(args, C, li); SEAM(base + 1); }
#endif

            #if SITE_ON(3)
        if (RUN(base + 2)) { nv_even_a(args, C, li); SEAM(base + 2); }
#endif

            #if SITE_ON(4)
        if (RUN(base + 3)) { nv_even_b(args, C); SEAM(base + 3); }
#endif

            #if SITE_ON(5)
        if (RUN(base + 4)) { nv_even_c(args, C); SEAM(base + 4); }
#endif

        } else {
            #if SITE_ON(6)
        if (RUN(base + 1)) { nv_odd_a(args, C, li); SEAM(base + 1); }
#endif

            #if SITE_ON(7)
        if (RUN(base + 2)) { nv_odd_b(args, C, li); SEAM(base + 2); }
#endif

        }
        #if SITE_ON(8)
        if (RUN(base + 9)) { WSL(ws);
            if (!odd) phase_even_normgate(args, C, li);
            else {
                pg8::StaticOrder S; S.init(ws + WS_SCR + SC_YS, ws + WS_WGL + li * SZ_WGL, 1024, 32, 4, C.G, (int)blockIdx.x);
                pg8::EpiGlu E{(const bf16*)(ws + WS_SCR + SC_YS), INF(29) + li * 1024, (bf16*)(ws + WS_YC)};
                pg8::gemm_phase<pg8::EpiGlu, pg8::StaticOrder, true, true>(C.lds, 1024, S, E);
                phase_odd_normgate(args, C, li);
            }
            SEAM(base + 9);
        }
#endif

        #if SITE_ON(9)
        if (RUN(base + 10)) { WSL(ws);
            pg8::StaticOrder S; S.init(ws + WS_YC, odd ? (ws + WS_WOO + li * SZ_WO) : (ws + WS_WOE + li * SZ_WO), 2048, 32, 8, C.G, (int)blockIdx.x);
            pg8::EpiWout E{layer == 0 ? INF(0) : (const float*)(ws + WS_XF), (float*)(ws + WS_Z), DN_ALPHA};
            pg8::gemm_phase<pg8::EpiWout, pg8::StaticOrder, true, true>(C.lds, 2048, S, E);
            SEAM(base + 10);
        }
#endif

        #if SITE_ON(10)
        if (RUN(base + 11)) { phase_ln_route(args, C, layer); SEAM(base + 11); }
#endif

        if (RUN(base + 12) || RUN(base + 13)) { WSL(ws);
            LAS int* tab = (LAS int*)(C.lds + MISC_OFF + 64);
            __syncthreads();
            if (C.tid == 0) { int pre = 0; const unsigned* cnt = (const unsigned*)(ws + WS_CTL) + CW_CNT + layer * 16 * 64;
                for (int e = 0; e < 16; ++e) { const int n = (int)__hip_atomic_load(cnt + e * 64, __ATOMIC_RELAXED, __HIP_MEMORY_SCOPE_AGENT); tab[e] = pre; tab[17 + e] = n; pre += (n + 255) >> 8; }
                tab[16] = pre; }
            __syncthreads();
            #if SITE_ON(11)
        if (RUN(base + 12)) {
                pg8::MoeOrder S{tab, (const char*)(ws + WS_XS), (const char*)(ws + WS_MW1 + (size_t)layer * 16 * SZ_MW1), (size_t)8192 * 2048 * 2, SZ_MW1, (size_t)256 * 2048 * 2, (size_t)256 * 2048 * 2, C.G, (int)blockIdx.x};
                pg8::EpiMoe1 E{(bf16*)(ws + WS_ACT)};
                pg8::gemm_phase<pg8::EpiMoe1, pg8::MoeOrder, true, true>(C.lds, 2048, S, E);
                SEAM(base + 12);
            }
#endif

            #if SITE_ON(12)
        if (RUN(base + 13)) {
                pg8::MoeOrder S{tab, (const char*)(ws + WS_ACT), (const char*)(ws + WS_MW2 + (size_t)layer * 16 * SZ_MW2), (size_t)8192 * 1024 * 2, SZ_MW2, (size_t)256 * 1024 * 2, (size_t)256 * 1024 * 2, C.G, (int)blockIdx.x};
                pg8::EpiMoe2 E{(const int*)(ws + WS_DST), (const float*)(ws + WS_GATE), (bf16*)(ws + WS_YB)};
                pg8::gemm_phase<pg8::EpiMoe2, pg8::MoeOrder, true, true>(C.lds, 1024, S, E);
                SEAM(base + 13);
            }
#endif

        }
        #if SITE_ON(13)
        if (RUN(base + 14)) { phase_ln_ffn(args, C, layer); SEAM(base + 14); }
#endif

    }
#undef RUN
#undef SEAM
}

extern "C" void kernel_launch(void* const* d_in, const int* in_sizes, int n_in, void* d_out, int out_size, void* d_ws, size_t ws_size, hipStream_t stream) {
    static int grid = 0;
    if (grid == 0) {
        if (n_in != 34 || out_size != T * D || ws_size < WS_END) { fprintf(stderr, "kernel_launch: unexpected shapes (n_in %d, out %d, ws %zu < %zu)\n", n_in, out_size, ws_size, (size_t)WS_END); grid = -1; return; }
        int dev = 0, cus = 0, per_cu = 0;
        if (hipGetDevice(&dev) != hipSuccess || hipDeviceGetAttribute(&cus, hipDeviceAttributeMultiprocessorCount, dev) != hipSuccess) { grid = -1; return; }
        if (hipFuncSetAttribute((const void*)trunk_fwd, hipFuncAttributeMaxDynamicSharedMemorySize, LDS_BYTES) != hipSuccess) { fprintf(stderr, "kernel_launch: hipFuncSetAttribute failed\n"); grid = -1; return; }
        if (hipOccupancyMaxActiveBlocksPerMultiprocessor(&per_cu, (const void*)trunk_fwd, NTHR, LDS_BYTES) != hipSuccess || per_cu < 1) { fprintf(stderr, "kernel_launch: occupancy query says %d blocks per CU\n", per_cu); }
        (void)hipGetLastError();
        grid = cus;
    }
    if (grid < 0) return;
    (void)in_sizes;
    if (hipMemsetAsync((char*)d_ws + WS_CTL, 0, CTL_BYTES, stream) != hipSuccess) return;
    Args a{};
    for (int i = 0; i < 34; ++i) a.in[i] = d_in[i];
    a.out = (float*)d_out; a.ws = (unsigned char*)d_ws;
#if MK_ONE_LAUNCH
    a.ph_lo = 0; a.ph_hi = PH_END;
    hipLaunchKernelGGL(trunk_fwd, dim3(grid), dim3(NTHR), LDS_BYTES, stream, a);
#else
    for (int ph = 0; ph < PH_END; ++ph) {
        if (ph > 0 && !slot_active((ph - 1) / 16, (ph - 1) % 16)) continue;
        a.ph_lo = ph; a.ph_hi = ph + 1;
        hipLaunchKernelGGL(trunk_fwd, dim3(grid), dim3(NTHR), LDS_BYTES, stream, a);
    }
#endif
}
```

```cpp
#include <hip/hip_runtime.h>
#include <cstdio>
#include <cstdint>

#ifndef MK_ONE_LAUNCH
#define MK_ONE_LAUNCH 1
#endif

namespace pg8 {
#define PG8_LAS __attribute__((address_space(3)))
typedef unsigned short bf16_t;
typedef short bf16x8 __attribute__((ext_vector_type(8)));
typedef float f32x4 __attribute__((ext_vector_type(4)));
typedef float f32x2 __attribute__((ext_vector_type(2)));
typedef unsigned u32x4 __attribute__((ext_vector_type(4)));
typedef unsigned u32x2 __attribute__((ext_vector_type(2)));
constexpr int BM = 256, BK = 64, HALF = 128, HTB = HALF * BK * 2  , STAGE_BYTES = 8 * HTB, NXCD = 8, WGM = 8;

__host__ __device__ __forceinline__ int lds_byte(int r, int c) { const int st = (r >> 4) * 2 + (c >> 5), rr = r & 15, cc = c & 31, ob = rr * 64 + cc * 2; return st * 1024 + (ob ^ (((ob >> 9) & 1) << 5)); }
__host__ __device__ __forceinline__ void stage_rc(int b, int& R, int& C) { const int st = b / 1024, sb = b % 1024, swz = sb ^ (((sb >> 9) & 1) << 5); R = (st >> 1) * 16 + swz / 64; C = (st & 1) * 32 + (swz % 64) / 2; }
__host__ __device__ __forceinline__ int perm32(int rho) { const int n = rho >> 4, i = rho & 15; return 8 * (i >> 2) + 4 * n + (i & 3); }

struct Unit { const char* A; const char* B; int pm, pn, e, rows; };

struct StaticOrder {
    const char* A0; const char* B0; size_t tstep; int nM, nN, nwg, G, c;
    __device__ void init(const void* A, const void* Bt, int K, int nM_, int nN_, int G_, int c_) { A0 = (const char*)A; B0 = (const char*)Bt; tstep = (size_t)BM * K * 2; nM = nM_; nN = nN_; nwg = nM * nN; G = G_; c = c_; }
    __device__ bool next(int i, Unit& u) const {
        const long L = (long)i * G + c; if (L >= nwg) return false;
        int wgid = (int)L; { const int q = nwg / NXCD, r = nwg % NXCD, xcd = wgid % NXCD, off = wgid / NXCD; wgid = (xcd < r ? xcd * (q + 1) : r * (q + 1) + (xcd - r) * q) + off; }
        const int nig = WGM * nN, gid = wgid / nig, fm = gid * WGM, gsz = (nM - fm) < WGM ? (nM - fm) : WGM;
        u.pm = fm + ((wgid % nig) % gsz); u.pn = (wgid % nig) / gsz; u.e = 0; u.rows = BM;
        u.A = A0 + (size_t)u.pm * tstep; u.B = B0 + (size_t)u.pn * tstep; return true;
    }
    __device__ __forceinline__ void a_ready(const Unit&) const {}
    __device__ __forceinline__ void done(const Unit&) const {}
};
struct MoeOrder {
    const PG8_LAS int* tab; const char* A0; const char* B0; size_t a_es, b_es, a_ts, b_ts; int G, c;
    __device__ bool next(int i, Unit& u) const {
        const long uid = (long)i * G + c; const int total = __builtin_amdgcn_readfirstlane(tab[16]) * 8; if (uid >= total) return false;
        const int nt = (int)(uid & 7), v = (int)(uid >> 3); int e = 0;
#pragma unroll
        for (int k = 1; k < 16; ++k) e += (v >= tab[k]) ? 1 : 0;
        e = __builtin_amdgcn_readfirstlane(e);
        const int mt = __builtin_amdgcn_readfirstlane(v - tab[e]);
        const int rows = __builtin_amdgcn_readfirstlane(tab[17 + e]) - mt * BM;
        u.e = e; u.pm = mt; u.pn = nt; u.rows = rows < BM ? rows : BM;
        u.A = A0 + (size_t)e * a_es + (size_t)mt * a_ts; u.B = B0 + (size_t)e * b_es + (size_t)nt * b_ts; return true;
    }
    __device__ __forceinline__ void a_ready(const Unit&) const {}
    __device__ __forceinline__ void done(const Unit&) const {}
};

__device__ __forceinline__ unsigned cvt_pk_bf16(float lo, float hi) { unsigned r; asm volatile("v_cvt_pk_bf16_f32 %0, %1, %2" : "=v"(r) : "v"(lo), "v"(hi)); return r; }
__device__ __forceinline__ f32x2 gelu_pk(f32x2 v) {
    const f32x2 av = __builtin_elementwise_abs(v), d = av * 0.2316418882f + 1.0f;
    f32x2 t; t.x = __builtin_amdgcn_rcpf(d.x); t.y = __builtin_amdgcn_rcpf(d.y);
    f32x2 q = t * 0.5307027145f + (-0.7265760135f); q = q * t + 0.7107068705f; q = q * t + (-0.142248368f); q = q * t + 0.127414796f; q = q * t;
    const f32x2 s = (v * v) * (-0.72134752044f);
    f32x2 e; e.x = __builtin_amdgcn_exp2f(s.x); e.y = __builtin_amdgcn_exp2f(s.y);
    const f32x2 m = v * (q * e), r = v - m;
    f32x2 o; o.x = v.x < 0.f ? m.x : r.x; o.y = v.y < 0.f ? m.y : r.y; return o;
}
__device__ __forceinline__ float sigmoid_f(float x) { return __builtin_amdgcn_rcpf(1.0f + __expf(-x)); }
__device__ __forceinline__ float bf_lo(unsigned w) { return __uint_as_float(w << 16); }
__device__ __forceinline__ float bf_hi(unsigned w) { return __uint_as_float(w & 0xffff0000u); }

struct EpiWin {
    static constexpr bool PERM = true, AFTER_DRAIN = false;
    bf16_t* O; int ldc; int gelu_tiles; int rot_lo, rot_hi, rot_q_hi; const float* cs; const float* sn;
    __device__ __forceinline__ void operator()(const f32x4 (&acc)[2][2][4][2], const Unit& u, int wr, int wc, int fr, int fq) const {
        asm volatile("" : "+v"(fr), "+v"(fq));
        const int row0 = u.pm * BM + wr * 64 + fr, col0 = u.pn * BM + wc * 32 + 8 * fq;
        const bool g = u.pn < gelu_tiles, rot = (u.pn >= rot_lo) && (u.pn < rot_hi);
        const float qs = (u.pn < rot_q_hi) ? 0.0625f : 1.0f;
#pragma unroll
        for (int ai = 0; ai < 2; ++ai)
#pragma unroll
            for (int m = 0; m < 4; ++m) { const int row = row0 + ai * HALF + m * 16; bf16_t* rowp = O + (size_t)row * ldc + col0;
                f32x4 v[2][2];
#pragma unroll
                for (int bj = 0; bj < 2; ++bj) { v[bj][0] = acc[ai][bj][m][0]; v[bj][1] = acc[ai][bj][m][1]; }
                if (g) {
#pragma unroll
                    for (int bj = 0; bj < 2; ++bj)
#pragma unroll
                        for (int n = 0; n < 2; ++n) { f32x2 a = gelu_pk((f32x2){v[bj][n][0], v[bj][n][1]}), b = gelu_pk((f32x2){v[bj][n][2], v[bj][n][3]}); v[bj][n] = (f32x4){a.x, a.y, b.x, b.y}; }
                }
                if (rot) {
                    const int fi = wc * 32 + 8 * fq;
#pragma unroll
                    for (int n = 0; n < 2; ++n) { const f32x4 c4 = *(const f32x4*)(cs + (size_t)row * 128 + fi + 4 * n), s4 = *(const f32x4*)(sn + (size_t)row * 128 + fi + 4 * n);
                        const f32x4 x1 = v[0][n], x2 = v[1][n]; v[0][n] = (x1 * c4 - x2 * s4) * qs; v[1][n] = (x1 * s4 + x2 * c4) * qs; }
                }
#pragma unroll
                for (int bj = 0; bj < 2; ++bj) { u32x4 w; w.x = cvt_pk_bf16(v[bj][0][0], v[bj][0][1]); w.y = cvt_pk_bf16(v[bj][0][2], v[bj][0][3]); w.z = cvt_pk_bf16(v[bj][1][0], v[bj][1][1]); w.w = cvt_pk_bf16(v[bj][1][2], v[bj][1][3]);
                    *(u32x4*)(rowp + bj * HALF) = w; } }
    }
};
struct EpiWout {
    static constexpr bool PERM = false, AFTER_DRAIN = false;
    const float* xres; float* Z; float alpha;
    __device__ __forceinline__ void operator()(const f32x4 (&acc)[2][2][4][2], const Unit& u, int wr, int wc, int fr, int fq) const {
        asm volatile("" : "+v"(fr), "+v"(fq));
        const int row0 = u.pm * BM + wr * 64 + fr, col0 = u.pn * BM + wc * 32 + 4 * fq;
#pragma unroll
        for (int ai = 0; ai < 2; ++ai)
#pragma unroll
            for (int m = 0; m < 4; ++m) { const size_t off = (size_t)(row0 + ai * HALF + m * 16) * 2048 + col0;
#pragma unroll
                for (int bj = 0; bj < 2; ++bj)
#pragma unroll
                    for (int n = 0; n < 2; ++n) { const f32x4 xr = *(const f32x4*)(xres + off + bj * HALF + n * 16); *(f32x4*)(Z + off + bj * HALF + n * 16) = xr * alpha + acc[ai][bj][m][n]; } }
    }
};
struct EpiGlu {
    static constexpr bool PERM = true, AFTER_DRAIN = false;
    const bf16_t* YS; const float* bias; bf16_t* YC;
    __device__ __forceinline__ void operator()(const f32x4 (&acc)[2][2][4][2], const Unit& u, int wr, int wc, int fr, int fq) const {
        asm volatile("" : "+v"(fr), "+v"(fq));
        const int row0 = u.pm * BM + wr * 64 + fr, col0 = u.pn * BM + wc * 32 + 8 * fq;
        f32x4 bv[2][2];
#pragma unroll
        for (int bj = 0; bj < 2; ++bj)
#pragma unroll
            for (int n = 0; n < 2; ++n) bv[bj][n] = *(const f32x4*)(bias + col0 + bj * HALF + 4 * n);
#pragma unroll
        for (int ai = 0; ai < 2; ++ai)
#pragma unroll
            for (int m = 0; m < 4; ++m) { const int row = row0 + ai * HALF + m * 16;
#pragma unroll
                for (int bj = 0; bj < 2; ++bj) { const u32x4 yw = *(const u32x4*)(YS + (size_t)row * 1024 + col0 + bj * HALF);
                    const f32x4 a0 = acc[ai][bj][m][0] + bv[bj][0], a1 = acc[ai][bj][m][1] + bv[bj][1];
                    u32x4 w;
                    w.x = cvt_pk_bf16(bf_lo(yw.x) * sigmoid_f(a0[0]), bf_hi(yw.x) * sigmoid_f(a0[1])); w.y = cvt_pk_bf16(bf_lo(yw.y) * sigmoid_f(a0[2]), bf_hi(yw.y) * sigmoid_f(a0[3]));
                    w.z = cvt_pk_bf16(bf_lo(yw.z) * sigmoid_f(a1[0]), bf_hi(yw.z) * sigmoid_f(a1[1])); w.w = cvt_pk_bf16(bf_lo(yw.w) * sigmoid_f(a1[2]), bf_hi(yw.w) * sigmoid_f(a1[3]));
                    *(u32x4*)(YC + (size_t)row * 2048 + col0 + bj * HALF) = w; } }
    }
};
struct EpiMoe1 {
    static constexpr bool PERM = true, AFTER_DRAIN = false;
    bf16_t* ACT;
    __device__ __forceinline__ void operator()(const f32x4 (&acc)[2][2][4][2], const Unit& u, int wr, int wc, int fr, int fq) const {
        asm volatile("" : "+v"(fr), "+v"(fq));
        const int col0 = u.pn * HALF + wc * 32 + 8 * fq;
        bf16_t* base = ACT + ((size_t)u.e * 8192 + (size_t)u.pm * BM) * 1024 + col0;
#pragma unroll
        for (int ai = 0; ai < 2; ++ai)
#pragma unroll
            for (int m = 0; m < 4; ++m) { const int r = ai * HALF + wr * 64 + m * 16 + fr;
                if (r < u.rows) { float o[8];
#pragma unroll
                    for (int n = 0; n < 2; ++n)
#pragma unroll
                        for (int j = 0; j < 4; ++j) { const float hg = acc[ai][0][m][n][j], hu = acc[ai][1][m][n][j]; o[4 * n + j] = hg * sigmoid_f(hg) * hu; }
                    u32x4 w; w.x = cvt_pk_bf16(o[0], o[1]); w.y = cvt_pk_bf16(o[2], o[3]); w.z = cvt_pk_bf16(o[4], o[5]); w.w = cvt_pk_bf16(o[6], o[7]);
                    *(u32x4*)(base + (size_t)r * 1024) = w; } }
    }
};
struct EpiMoe2 {
    static constexpr bool PERM = true, AFTER_DRAIN = false;
    const int* dst; const float* gate; bf16_t* YB;
    __device__ __forceinline__ void operator()(const f32x4 (&acc)[2][2][4][2], const Unit& u, int wr, int wc, int fr, int fq) const {
        asm volatile("" : "+v"(fr), "+v"(fq));
        const int col0 = u.pn * BM + wc * 32 + 8 * fq; const size_t rb = (size_t)u.e * 8192 + (size_t)u.pm * BM;
#pragma unroll
        for (int ai = 0; ai < 2; ++ai)
#pragma unroll
            for (int m = 0; m < 4; ++m) { const int r = ai * HALF + wr * 64 + m * 16 + fr;
                if (r < u.rows) { const int d = dst[rb + r]; const float gt = gate[rb + r]; bf16_t* rowp = YB + (size_t)d * 2048 + col0;
#pragma unroll
                    for (int bj = 0; bj < 2; ++bj) { const f32x4 v0 = acc[ai][bj][m][0] * gt, v1 = acc[ai][bj][m][1] * gt;
                        u32x4 w; w.x = cvt_pk_bf16(v0[0], v0[1]); w.y = cvt_pk_bf16(v0[2], v0[3]); w.z = cvt_pk_bf16(v1[0], v1[1]); w.w = cvt_pk_bf16(v1[2], v1[3]);
                        *(u32x4*)(rowp + bj * HALF) = w; } } }
    }
};

template <class Epi, class Sched, bool ALIGN_EPI = false, bool SP2 = false>
__device__ __forceinline__ void gemm_phase(PG8_LAS unsigned char* lds, const int Kdim, const Sched& S, const Epi& E) {
    int tid_ = threadIdx.x; asm volatile("" : "+v"(tid_));
    const int tid = tid_, wid = __builtin_amdgcn_readfirstlane(tid >> 6), lane = tid & 63, wr = wid >> 2, wc = wid & 3, fr = lane & 15, fq = lane >> 4;
    const int K = Kdim, nt = K / BK;
    unsigned voffA[2], voffB[2];
#pragma unroll
    for (int i = 0; i < 2; ++i) { int R, C; stage_rc(tid * 16 + i * 8192, R, C); const int Rb = Epi::PERM ? ((R & ~31) + perm32(R & 31)) : R;
        voffA[i] = (unsigned)(R * K + C) * 2u; voffB[i] = (unsigned)(Rb * K + C) * 2u; }
    const size_t kstep = (size_t)(BK * 2);
    const size_t hstep = (size_t)HALF * K * 2;
    const unsigned ldsw = (unsigned)wid * 1024u;
    const int aoff = lds_byte(wr * 64 + fr, fq * 8), boff = lds_byte(wc * 32 + fr, fq * 8);
#define PG8_SA(b, h) (((b) * 2 + (h)) * HTB)
#define PG8_SB(b, h) ((4 + (b) * 2 + (h)) * HTB)
#define PG8_STAGE(bufoff, gbase, voff) do { _Pragma("unroll") for (int _i = 0; _i < 2; ++_i) \
        __builtin_amdgcn_global_load_lds((const unsigned*)((const char*)(gbase) + (voff)[_i]), (PG8_LAS unsigned*)(lds + (bufoff) + ldsw + _i * 8192), 16, 0, 0); } while (0)
#define PG8_LDA(dst, b, h) do { _Pragma("unroll") for (int m = 0; m < 4; ++m) _Pragma("unroll") for (int k = 0; k < 2; ++k) dst[m][k] = *(const PG8_LAS bf16x8*)(lds + PG8_SA(b, h) + aoff + m * 2048 + k * 1024); } while (0)
#define PG8_LDB(dst, b, h) do { _Pragma("unroll") for (int n = 0; n < 2; ++n) _Pragma("unroll") for (int k = 0; k < 2; ++k) dst[n][k] = *(const PG8_LAS bf16x8*)(lds + PG8_SB(b, h) + boff + n * 2048 + k * 1024); } while (0)
#define PG8_MMA(ai, bj, At, Bt) do { __builtin_amdgcn_s_setprio(1); _Pragma("unroll") for (int m = 0; m < 4; ++m) _Pragma("unroll") for (int n = 0; n < 2; ++n) _Pragma("unroll") for (int k = 0; k < 2; ++k) \
        acc[ai][bj][m][n] = __builtin_amdgcn_mfma_f32_16x16x32_bf16(Bt[n][k], At[m][k], acc[ai][bj][m][n], 0, 0, 0); __builtin_amdgcn_s_setprio(0); } while (0)
#define PG8_WAIT_V(n) asm volatile("s_waitcnt vmcnt(" #n ")" ::: "memory")
#define PG8_WAIT_L(n) asm volatile("s_waitcnt lgkmcnt(" #n ")" ::: "memory")
#define PG8_BAR __builtin_amdgcn_s_barrier()
#define PG8_SCHED __builtin_amdgcn_sched_barrier(0)
    Unit cur, nxt; int ui = 0;
    if (!S.next(0, cur)) return;
    f32x4 acc[2][2][4][2];
#pragma unroll
    for (int a = 0; a < 2; ++a)
#pragma unroll
        for (int b = 0; b < 2; ++b)
#pragma unroll
            for (int m = 0; m < 4; ++m)
#pragma unroll
                for (int n = 0; n < 2; ++n) acc[a][b][m][n] = (f32x4){0.f, 0.f, 0.f, 0.f};
    bf16x8 At[4][2], B0[2][2], B1[2][2];
    const char* cA = cur.A; const char* cB = cur.B;
    S.a_ready(cur);
    if constexpr (SP2) {
        PG8_STAGE(PG8_SB(0, 0), cB, voffB); PG8_STAGE(PG8_SB(0, 1), cB + hstep, voffB); PG8_STAGE(PG8_SA(0, 0), cA, voffA); PG8_STAGE(PG8_SA(0, 1), cA + hstep, voffA);
        if (wr == 1) PG8_BAR;
        PG8_WAIT_V(2); PG8_BAR;
        PG8_STAGE(PG8_SB(1, 0), cB + kstep, voffB); PG8_STAGE(PG8_SA(1, 0), cA + kstep, voffA); PG8_STAGE(PG8_SB(1, 1), cB + hstep + kstep, voffB);
        PG8_WAIT_V(6); PG8_BAR;
    } else {
        PG8_STAGE(PG8_SB(0, 0), cB, voffB); PG8_STAGE(PG8_SA(0, 0), cA, voffA); PG8_STAGE(PG8_SB(0, 1), cB + hstep, voffB); PG8_STAGE(PG8_SA(0, 1), cA + hstep, voffA);
        if (wr == 1) PG8_BAR;
        PG8_WAIT_V(4); PG8_BAR;
        PG8_STAGE(PG8_SB(1, 0), cB + kstep, voffB); PG8_STAGE(PG8_SA(1, 0), cA + kstep, voffA); PG8_STAGE(PG8_SB(1, 1), cB + hstep + kstep, voffB);
        PG8_WAIT_V(6); PG8_BAR;
    }
    for (;;) {
        const bool has_next = S.next(ui + 1, nxt);
        const char* nA = has_next ? nxt.A : cA; const char* nB = has_next ? nxt.B : cB;
        for (int t = 0; t < nt; t += 2) {
            const bool last = (t == nt - 2);
            const char* a1 = cA + (size_t)(t + 1) * kstep;
            const char* a2 = last ? nA : cA + (size_t)(t + 2) * kstep; const char* b2 = last ? nB : cB + (size_t)(t + 2) * kstep;
            const char* a3 = a2 + kstep; const char* b3 = b2 + kstep;
            if (last && has_next) S.a_ready(nxt);
            if constexpr (SP2) {
            PG8_LDB(B0, 0, 0); PG8_LDB(B1, 0, 1); PG8_SCHED; PG8_LDA(At, 0, 0); PG8_STAGE(PG8_SA(1, 1), a1 + hstep, voffA);
            PG8_WAIT_V(8); PG8_WAIT_L(0); PG8_BAR; PG8_MMA(0, 0, At, B0); PG8_MMA(0, 1, At, B1); PG8_BAR; PG8_SCHED;
            PG8_LDA(At, 0, 1); PG8_STAGE(PG8_SB(0, 0), b2, voffB); PG8_STAGE(PG8_SB(0, 1), b2 + hstep, voffB); PG8_STAGE(PG8_SA(0, 0), a2, voffA);
            PG8_WAIT_V(8); PG8_WAIT_L(0); PG8_BAR; PG8_MMA(1, 0, At, B0); PG8_MMA(1, 1, At, B1); PG8_BAR; PG8_SCHED;
            PG8_LDB(B0, 1, 0); PG8_LDB(B1, 1, 1); PG8_SCHED; PG8_LDA(At, 1, 0); PG8_STAGE(PG8_SA(0, 1), a2 + hstep, voffA);
            PG8_WAIT_V(8); PG8_WAIT_L(0); PG8_BAR; PG8_MMA(0, 0, At, B0); PG8_MMA(0, 1, At, B1); PG8_BAR; PG8_SCHED;
            PG8_LDA(At, 1, 1); PG8_STAGE(PG8_SB(1, 0), b3, voffB); PG8_STAGE(PG8_SB(1, 1), b3 + hstep, voffB); PG8_STAGE(PG8_SA(1, 0), a3, voffA);
            PG8_WAIT_V(8); PG8_WAIT_L(0); PG8_BAR; PG8_MMA(1, 0, At, B0); PG8_MMA(1, 1, At, B1); PG8_BAR; PG8_SCHED;
            } else {
            PG8_LDB(B0, 0, 0); PG8_SCHED; PG8_LDA(At, 0, 0); PG8_STAGE(PG8_SA(1, 1), a1 + hstep, voffA);
            PG8_WAIT_L(8); PG8_BAR; PG8_WAIT_L(0); PG8_MMA(0, 0, At, B0); PG8_BAR; PG8_SCHED;
            PG8_LDB(B1, 0, 1); PG8_STAGE(PG8_SB(0, 0), b2, voffB);
            PG8_BAR; PG8_WAIT_L(0); PG8_MMA(0, 1, At, B1); PG8_BAR;
            PG8_LDA(At, 0, 1); PG8_STAGE(PG8_SA(0, 0), a2, voffA);
            PG8_BAR; PG8_WAIT_L(0); PG8_MMA(1, 0, At, B0); PG8_BAR; PG8_SCHED;
            PG8_STAGE(PG8_SB(0, 1), b2 + hstep, voffB);
            PG8_WAIT_V(6); PG8_BAR; PG8_MMA(1, 1, At, B1); PG8_BAR;
            PG8_LDB(B0, 1, 0); PG8_SCHED; PG8_LDA(At, 1, 0); PG8_STAGE(PG8_SA(0, 1), a2 + hstep, voffA);
            PG8_WAIT_L(8); PG8_BAR; PG8_WAIT_L(0); PG8_MMA(0, 0, At, B0); PG8_BAR; PG8_SCHED;
            PG8_LDB(B1, 1, 1); PG8_STAGE(PG8_SB(1, 0), b3, voffB);
            PG8_BAR; PG8_WAIT_L(0); PG8_MMA(0, 1, At, B1); PG8_BAR;
            PG8_LDA(At, 1, 1); PG8_STAGE(PG8_SA(1, 0), a3, voffA);
            PG8_BAR; PG8_WAIT_L(0); PG8_MMA(1, 0, At, B0); PG8_BAR; PG8_SCHED;
            PG8_STAGE(PG8_SB(1, 1), b3 + hstep, voffB);
            PG8_WAIT_V(6); PG8_BAR; PG8_MMA(1, 1, At, B1); PG8_BAR;
            }
        }
        if constexpr (ALIGN_EPI) { if (wr == 0) PG8_BAR; }
        if constexpr (!Epi::AFTER_DRAIN) { E(acc, cur, wr, wc, fr, fq); S.done(cur); }
        if (!has_next) break;
#pragma unroll
        for (int a = 0; a < 2; ++a)
#pragma unroll
            for (int b = 0; b < 2; ++b)
#pragma unroll
                for (int m = 0; m < 4; ++m)
#pragma unroll
                    for (int n = 0; n < 2; ++n) acc[a][b][m][n] = (f32x4){0.f, 0.f, 0.f, 0.f};
        cur = nxt; cA = nA; cB = nB; ++ui;
        if constexpr (ALIGN_EPI) { if (wr == 1) PG8_BAR; }
    }
    PG8_WAIT_V(0);
    if constexpr (!ALIGN_EPI) { if (wr == 0) PG8_BAR; }
    PG8_BAR;
    if constexpr (Epi::AFTER_DRAIN) { E.fused(acc, cur, wr, wc, fr, fq, lds, wid, lane); S.done(cur); }
#undef PG8_SA
#undef PG8_SB
#undef PG8_STAGE
#undef PG8_LDA
#undef PG8_LDB
#undef PG8_MMA
#undef PG8_WAIT_V
#undef PG8_WAIT_L
#undef PG8_BAR
#undef PG8_SCHED
}
}

constexpr int NWAVES = 8, NTHR = 512;
constexpr int T = 8192, D = 2048, SEQ = 2048;
constexpr int HE = 6144, HO = 5376, HO_SRC = 5136;
constexpr int DEPTH = 4;
constexpr float DN_ALPHA = 1.681792830507429f;
constexpr float LN_EPS = 1e-5f, RMS_EPS = 1e-6f;

#ifndef FAST_GATE
#define FAST_GATE 1
#endif
#ifndef FAST_RET
#define FAST_RET 1
#endif
#ifndef FAST_S5
#define FAST_S5 1
#endif
#ifndef FAST_DN
#define FAST_DN 1
#endif

constexpr size_t MiB = 1ull << 20;
constexpr size_t WS_CTL = 0, CTL_BYTES = MiB;
constexpr size_t SZ_WIE = 24 * MiB, SZ_WIO = 21 * MiB, SZ_WO = 8 * MiB, SZ_WGL = 2 * MiB, SZ_MW1 = 8 * MiB, SZ_MW2 = 4 * MiB;
constexpr size_t WS_WIE = WS_CTL + CTL_BYTES;
constexpr size_t WS_WIO = WS_WIE + 2 * SZ_WIE;
constexpr size_t WS_WOE = WS_WIO + 2 * SZ_WIO;
constexpr size_t WS_WOO = WS_WOE + 2 * SZ_WO;
constexpr size_t WS_WGL = WS_WOO + 2 * SZ_WO;
constexpr size_t WS_MW1 = WS_WGL + 2 * SZ_WGL;
constexpr size_t WS_MW2 = WS_MW1 + 64 * SZ_MW1;
constexpr size_t WS_COS = WS_MW2 + 64 * SZ_MW2;
constexpr size_t WS_SIN = WS_COS + 4 * MiB;
constexpr size_t WS_XF = WS_SIN + 4 * MiB;
constexpr size_t WS_Z = WS_XF + 64 * MiB;
constexpr size_t WS_XB = WS_Z + 64 * MiB;
constexpr size_t WS_H = WS_XB + 32 * MiB;
constexpr size_t WS_YC = WS_H + 96 * MiB;
constexpr size_t WS_XS = WS_YC + 32 * MiB;
constexpr size_t WS_ACT = WS_XS + 512 * MiB;
constexpr size_t WS_YB = WS_ACT + 256 * MiB;
constexpr size_t WS_DST = WS_YB + 64 * MiB;
constexpr size_t WS_GATE = WS_DST + MiB;
constexpr size_t WS_SCR = WS_GATE + MiB;
constexpr size_t SCR_BYTES = 640 * MiB;
constexpr size_t WS_END = WS_SCR + SCR_BYTES;
constexpr size_t SC_OI = 0;
constexpr size_t SC_OS = 32 * MiB;
constexpr size_t SC_VLN = 64 * MiB;
constexpr size_t SC_QR = 96 * MiB, SC_KR = 128 * MiB;
constexpr size_t SC_SC = 160 * MiB;
constexpr size_t SC_KV = 168 * MiB;
constexpr size_t SC_YS = 0;
constexpr size_t SC_X5 = 64 * MiB;
constexpr size_t SC_QN = 320 * MiB, SC_KN = 352 * MiB, SC_VN = 384 * MiB;
constexpr size_t SC_BETA = 416 * MiB, SC_G = 417 * MiB;
constexpr size_t SC_DO = 32 * MiB;
static_assert(SC_KV + 128 * MiB <= SCR_BYTES && SC_G + MiB <= SCR_BYTES, "scratch map");
constexpr int CW_BAR = 4096;
constexpr int CW_CNT = 16384;
static_assert((CW_CNT + 64 * 64) * 4 <= (int)CTL_BYTES, "ctl");

constexpr int RING_BYTES = 131072;
constexpr int MISC_OFF = 147456 - 256;
constexpr int LDS_BYTES = 147456;

#define LAS __attribute__((address_space(3)))
#define GAS __attribute__((address_space(1)))
typedef unsigned short bf16;
typedef float f32x4 __attribute__((ext_vector_type(4)));
typedef float f32x2 __attribute__((ext_vector_type(2)));
typedef unsigned v4u __attribute__((ext_vector_type(4)));
typedef unsigned v2u __attribute__((ext_vector_type(2)));
#define LDS_WAIT() asm volatile("s_waitcnt lgkmcnt(0)" ::: "memory")
#define VM_WAIT() asm volatile("s_waitcnt vmcnt(0)" ::: "memory")
__device__ __forceinline__ unsigned f2bf(float f) { unsigned u = __builtin_bit_cast(unsigned, f); return (u + 0x7fffu + ((u >> 16) & 1u)) >> 16; }
__device__ __forceinline__ unsigned pk2(float lo, float hi) { return f2bf(lo) | (f2bf(hi) << 16); }
__device__ __forceinline__ float bf2f(bf16 b) { return __uint_as_float(((unsigned)b) << 16); }
#define DPP_XOR1 0xB1
#define DPP_XOR2 0x4E
__device__ __forceinline__ float wave_sum(float v) {
    v += __builtin_bit_cast(float, __builtin_amdgcn_mov_dpp(__builtin_bit_cast(int, v), 0xB1, 0xF, 0xF, true));
    v += __builtin_bit_cast(float, __builtin_amdgcn_mov_dpp(__builtin_bit_cast(int, v), 0x4E, 0xF, 0xF, true));
    v += __builtin_bit_cast(float, __builtin_amdgcn_mov_dpp(__builtin_bit_cast(int, v), 0x141, 0xF, 0xF, true));
    v += __builtin_bit_cast(float, __builtin_amdgcn_mov_dpp(__builtin_bit_cast(int, v), 0x140, 0xF, 0xF, true));
    v += __builtin_bit_cast(float, __builtin_amdgcn_ds_swizzle(__builtin_bit_cast(int, v), 0x401F));
    return __builtin_bit_cast(float, __builtin_amdgcn_readlane(__builtin_bit_cast(int, v), 0)) + __builtin_bit_cast(float, __builtin_amdgcn_readlane(__builtin_bit_cast(int, v), 32));
}
__device__ __forceinline__ float quad_sum(float v) {
    v += __builtin_bit_cast(float, __builtin_amdgcn_mov_dpp(__builtin_bit_cast(int, v), 0xB1, 0xF, 0xF, true));
    v += __builtin_bit_cast(float, __builtin_amdgcn_mov_dpp(__builtin_bit_cast(int, v), 0x4E, 0xF, 0xF, true));
    return v;
}
__device__ __forceinline__ float silu_f(float x) { return x / (1.0f + __expf(-x)); }

#define XB_TMO      128
#define XB_XCNT(j)  (256  + 64 * (j))
#define XB_XSUB(j)  (1280 + 64 * (j))
#define XB_XGEN(j)  (2304 + 64 * (j))
#define XB_TOP      3328
#define XB_TOPGEN   3392
#define XCD_BAR_WORDS 3456
#define XB_SPIN_CAP (1u << 22)

__device__ __forceinline__ unsigned xb_ld(unsigned* p)              { return __hip_atomic_load(p, __ATOMIC_RELAXED, __HIP_MEMORY_SCOPE_AGENT); }
__device__ __forceinline__ unsigned xb_add(unsigned* p, unsigned v) { return __hip_atomic_fetch_add(p, v, __ATOMIC_RELAXED, __HIP_MEMORY_SCOPE_AGENT); }
__device__ __forceinline__ unsigned xb_xcc_id() { return (unsigned)__builtin_amdgcn_s_getreg((3 << 11) | 20) & 0xFu; }
#define XB_SPIN(cond, bar) do { unsigned _sp = 0; while (cond) { __builtin_amdgcn_s_sleep(1); \
    if ((++_sp & 255u) == 0u) { if (xb_ld(&(bar)[XB_TMO])) break; if (_sp > XB_SPIN_CAP) { atomicAdd(&(bar)[XB_TMO], 1u); break; } } } } while (0)

struct XcdBarrier { unsigned* bar; unsigned x; volatile LAS unsigned* st; };

__device__ __forceinline__ XcdBarrier xcd_barrier_post(unsigned* bar, volatile LAS unsigned* st) {
    XcdBarrier b; b.bar = bar; b.x = xb_xcc_id(); b.st = st;
    if (threadIdx.x == 0) (void)xb_add(&bar[XB_XCNT(b.x)], 1u);
    return b;
}
__device__ __forceinline__ void xcd_barrier_complete(unsigned* bar, unsigned x, unsigned& nloc, unsigned& nx) {
    const unsigned G = gridDim.x * gridDim.y * gridDim.z;
    unsigned sum, cnt, mine, sp = 0u;
    for (;;) {
        sum = 0u; cnt = 0u; mine = 0u;
#pragma unroll
        for (unsigned j = 0; j < 16; ++j) { const unsigned c = xb_ld(&bar[XB_XCNT(j)]); sum += c; cnt += (c > 0u) ? 1u : 0u; mine = (j == x) ? c : mine; }
        if (sum == G) break;
        __builtin_amdgcn_s_sleep(1);
        if ((++sp & 255u) == 0u) { if (xb_ld(&bar[XB_TMO])) break; if (sp > XB_SPIN_CAP) { atomicAdd(&bar[XB_TMO], 1u); break; } }
    }
    nloc = mine > 0u ? mine : 1u; nx = cnt > 0u ? cnt : 1u;
}
__device__ __forceinline__ void xcd_barrier(const XcdBarrier& b) {
    asm volatile("s_waitcnt vmcnt(0)" ::: "memory");
    __syncthreads();
    if (threadIdx.x == 0) {
        unsigned* bar = b.bar; unsigned bx = b.x;
        asm volatile("" : "+s"(bar), "+s"(bx));
        __builtin_amdgcn_s_waitcnt(0);
        unsigned nloc = b.st[0], nx = b.st[1];
        if (nloc == 0u) { xcd_barrier_complete(bar, bx, nloc, nx); b.st[0] = nloc; b.st[1] = nx; }
        const unsigned old = xb_add(&bar[XB_XSUB(bx)], 1u);
        const unsigned gen = old / nloc;
        if (old + 1u == (gen + 1u) * nloc) {
            __builtin_amdgcn_fence(__ATOMIC_RELEASE, "agent");
            asm volatile("s_waitcnt vmcnt(0)" ::: "memory");
            const unsigned og = xb_add(&bar[XB_TOP], 1u);
            const unsigned tg = og / nx;
            if (og + 1u == (tg + 1u) * nx) xb_add(&bar[XB_TOPGEN], 1u);
            else XB_SPIN(xb_ld(&bar[XB_TOPGEN]) == tg, bar);
            __builtin_amdgcn_fence(__ATOMIC_ACQUIRE, "agent");
            xb_add(&bar[XB_XGEN(bx)], 1u);
            asm volatile("s_waitcnt vmcnt(0)" ::: "memory");
        } else {
            XB_SPIN(xb_ld(&bar[XB_XGEN(bx)]) == gen, bar);
            __builtin_amdgcn_fence(__ATOMIC_ACQUIRE, "agent");
            asm volatile("s_waitcnt vmcnt(0)" ::: "memory");
        }
    }
    __syncthreads();
}

struct Args { const void* in[34]; float* out; unsigned char* ws; int ph_lo, ph_hi; };
typedef __attribute__((address_space(4))) const char karg_char;
__device__ __forceinline__ const void* argp(int i) {
    karg_char* kp = (karg_char*)__builtin_amdgcn_kernarg_segment_ptr();
    asm volatile("" : "+s"(kp));
    typedef const void* gptr_t; typedef __attribute__((address_space(4))) const gptr_t karg_ptr_t;
    return *(karg_ptr_t*)(kp + 8 * i);
}
#define INF(i) ((const float*)argp(i))

struct Ctx { LAS unsigned char* lds; unsigned char* ws; int tid, lane, wave, G, gw, NGW, bid; size_t gtid, gsz; };
__device__ __forceinline__ Ctx fresh(const Ctx& C0) { Ctx C = C0; unsigned long long z = 0ull; asm volatile("" : "+v"(C.tid), "+s"(z), "+s"(C.bid)); C.ws = C0.ws + z;
    C.lane = C.tid & 63; C.gw = C.bid * 8 + C.wave; C.gtid = (size_t)C.bid * 512 + C.tid; return C; }

__device__ __forceinline__ void conv_item(const float* W, int K, int Nsrc, int src_n0, bf16* WT, int dst_n0, int k0, LAS float* scr, int lane) {
    const int sc = src_n0 + (lane & 31); const bool ok = sc < Nsrc; const GAS float* Wg = (const GAS float*)W;
#pragma unroll 8
    for (int i = 0; i < 32; ++i) { const int kk = 2 * i + (lane >> 5); scr[kk * 33 + (lane & 31)] = ok ? Wg[(size_t)(k0 + kk) * Nsrc + sc] : 0.f; }
    LDS_WAIT(); asm volatile("" ::: "memory");
    const int c = lane & 7;
#pragma unroll
    for (int j = 0; j < 4; ++j) { const int n = (lane >> 3) + 8 * j; const LAS float* s = scr + (8 * c) * 33 + n;
        v4u o; o.x = pk2(s[0 * 33], s[1 * 33]); o.y = pk2(s[2 * 33], s[3 * 33]); o.z = pk2(s[4 * 33], s[5 * 33]); o.w = pk2(s[6 * 33], s[7 * 33]);
        *(v4u*)(WT + (size_t)(dst_n0 + n) * K + k0 + 8 * c) = o; }
    LDS_WAIT(); asm volatile("" ::: "memory");
}
__device__ __forceinline__ void conv_matrix(const Ctx& C, const float* W, int K, int Nsrc, int Ndst, bf16* WT, int map) {
    LAS float* scr = (LAS float*)(C.lds + C.wave * 8448);
    const int nblk = Ndst / 32, items = (K / 64) * nblk;
    for (int it = C.gw; it < items; it += C.NGW) {
        const int kb = it / nblk, nb = it % nblk, n0 = 32 * nb;
        int s0 = n0;
        if (map == 1) { const int tile = n0 >> 8, within = n0 & 255; s0 = (within < 128) ? (128 * tile + within) : (1024 + 128 * tile + within - 128); }
        conv_item(W, K, Nsrc, s0, WT, n0, 64 * kb, scr, C.lane);
    }
}
__device__ __forceinline__ void phase_prologue(const Args& args, const Ctx& C0) {
    const Ctx C = fresh(C0);
    unsigned char* ws = C.ws;
    for (int i = 0; i < 2; ++i) {
        conv_matrix(C, INF(10) + (size_t)i * 2048 * 6144, 2048, 6144, 6144, (bf16*)(ws + WS_WIE + i * SZ_WIE), 0);
        conv_matrix(C, INF(18) + (size_t)i * 2048 * HO_SRC, 2048, HO_SRC, HO, (bf16*)(ws + WS_WIO + i * SZ_WIO), 0);
        conv_matrix(C, INF(11) + (size_t)i * 2048 * 2048, 2048, 2048, 2048, (bf16*)(ws + WS_WOE + i * SZ_WO), 0);
        conv_matrix(C, INF(19) + (size_t)i * 2048 * 2048, 2048, 2048, 2048, (bf16*)(ws + WS_WOO + i * SZ_WO), 0);
        conv_matrix(C, INF(28) + (size_t)i * 1024 * 1024, 1024, 1024, 1024, (bf16*)(ws + WS_WGL + i * SZ_WGL), 0);
    }
    for (int le = 0; le < 64; ++le) {
        conv_matrix(C, INF(8) + (size_t)le * 2048 * 2048, 2048, 2048, 2048, (bf16*)(ws + WS_MW1 + le * SZ_MW1), 1);
        conv_matrix(C, INF(9) + (size_t)le * 1024 * 2048, 1024, 2048, 2048, (bf16*)(ws + WS_MW2 + le * SZ_MW2), 0);
    }
    const int* pos = (const int*)argp(1); float* cs = (float*)(ws + WS_COS); float* sn = (float*)(ws + WS_SIN);
    for (size_t i = C.gtid; i < (size_t)T * 128; i += C.gsz) { const int tok = (int)(i >> 7), f = (int)(i & 127);
        const float inv = powf(10000.0f, -(float)f / 128.0f); const float ang = (float)pos[tok] * inv; cs[i] = cosf(ang); sn[i] = sinf(ang); }
    const float* x = INF(0); bf16* XB = (bf16*)(ws + WS_XB);
    for (size_t i = C.gtid; i < (size_t)T * D / 4; i += C.gsz) { const f32x4 v = *(const f32x4*)(x + 4 * i); v2u o; o.x = pk2(v.x, v.y); o.y = pk2(v.z, v.w); *(v2u*)(XB + 4 * i) = o; }
}

__device__ __forceinline__ void ln_row(f32x4 (&v)[8], const float* g, const float* b, int lane) {
    float s = 0.f;
#pragma unroll
    for (int j = 0; j < 8; ++j) s += (v[j].x + v[j].y) + (v[j].z + v[j].w);
    const float mean = wave_sum(s) * (1.f / 2048.f); float s2 = 0.f;
#pragma unroll
    for (int j = 0; j < 8; ++j) { v[j] = v[j] - mean; s2 += (v[j].x * v[j].x + v[j].y * v[j].y) + (v[j].z * v[j].z + v[j].w * v[j].w); }
    const float rstd = 1.0f / sqrtf(wave_sum(s2) * (1.f / 2048.f) + LN_EPS);
#pragma unroll
    for (int j = 0; j < 8; ++j) { const f32x4 gg = *(const f32x4*)(g + 4 * lane + 256 * j), bb = *(const f32x4*)(b + 4 * lane + 256 * j); v[j] = v[j] * rstd * gg + bb; }
}
__device__ __forceinline__ void phase_ln_route(const Args& args, const Ctx& C0, int layer) {
    const Ctx C = fresh(C0);
    unsigned char* ws = C.ws;
    const float* Z = (const float*)(ws + WS_Z); float* XF = (float*)(ws + WS_XF); bf16* XS = (bf16*)(ws + WS_XS);
    int* DST = (int*)(ws + WS_DST); float* GATE = (float*)(ws + WS_GATE); unsigned* cnt = (unsigned*)(ws + WS_CTL) + CW_CNT + layer * 16 * 64;
    const float* g = INF(4) + layer * 2048; const float* b = INF(5) + layer * 2048; const float* wr = INF(2); const float* rb = INF(3);
    const int lane = C.lane;
    for (int row = C.gw; row < T; row += C.NGW) {
        f32x4 v[8];
#pragma unroll
        for (int j = 0; j < 8; ++j) v[j] = *(const f32x4*)(Z + (size_t)row * 2048 + 4 * lane + 256 * j);
        ln_row(v, g, b, lane);
#pragma unroll
        for (int j = 0; j < 8; ++j) *(f32x4*)(XF + (size_t)row * 2048 + 4 * lane + 256 * j) = v[j];
        float lg[16];
#pragma unroll
        for (int e = 0; e < 16; ++e) lg[e] = 0.f;
#pragma unroll
        for (int j = 0; j < 8; ++j)
#pragma unroll
            for (int q = 0; q < 4; ++q) { const float xv = v[j][q]; const float* wrow = wr + (size_t)(4 * lane + 256 * j + q) * 16;
#pragma unroll
                for (int e4 = 0; e4 < 4; ++e4) { const f32x4 w4 = *(const f32x4*)(wrow + 4 * e4); lg[4 * e4 + 0] += xv * w4.x; lg[4 * e4 + 1] += xv * w4.y; lg[4 * e4 + 2] += xv * w4.z; lg[4 * e4 + 3] += xv * w4.w; } }
#pragma unroll
        for (int e = 0; e < 16; ++e) lg[e] = wave_sum(lg[e]);
        float mx = lg[0];
#pragma unroll
        for (int e = 1; e < 16; ++e) mx = fmaxf(mx, lg[e]);
        float pr[16], sum = 0.f;
#pragma unroll
        for (int e = 0; e < 16; ++e) { pr[e] = expf(lg[e] - mx); sum += pr[e]; }
        const float rs = 1.0f / sum;
        float sel[16];
#pragma unroll
        for (int e = 0; e < 16; ++e) { pr[e] *= rs; sel[e] = pr[e] + rb[e]; }
        int grp = 0; float best = -3.0e38f;
#pragma unroll
        for (int gi = 0; gi < 4; ++gi) { const float a0 = sel[4 * gi], a1 = sel[4 * gi + 1], a2 = sel[4 * gi + 2], a3 = sel[4 * gi + 3];
            const float tot = (a0 + a1) + (a2 + a3), mn1 = fminf(fminf(a0, a1), fminf(a2, a3));
            const float h01 = fmaxf(a0, a1), l01 = fminf(a0, a1), h23 = fmaxf(a2, a3), l23 = fminf(a2, a3);
            const float top1 = fmaxf(h01, h23), top2 = fmaxf(fminf(h01, h23), fmaxf(l01, l23));
            (void)tot; (void)mn1;
            const float sc = top1 + top2; if (sc > best) { best = sc; grp = gi; } }
        float s4[4], p4[4];
#pragma unroll
        for (int k = 0; k < 4; ++k) { s4[k] = 0.f; p4[k] = 0.f; }
#pragma unroll
        for (int gi = 0; gi < 4; ++gi)
#pragma unroll
            for (int k = 0; k < 4; ++k) { s4[k] = (gi == grp) ? sel[4 * gi + k] : s4[k]; p4[k] = (gi == grp) ? pr[4 * gi + k] : p4[k]; }
        int i1 = 0; float b1 = s4[0];
#pragma unroll
        for (int k = 1; k < 4; ++k) if (s4[k] > b1) { b1 = s4[k]; i1 = k; }
        int i2 = -1; float b2 = -3.0e38f;
#pragma unroll
        for (int k = 0; k < 4; ++k) if (k != i1 && s4[k] > b2) { b2 = s4[k]; i2 = k; }
        float g1 = 0.f, g2 = 0.f;
#pragma unroll
        for (int k = 0; k < 4; ++k) { g1 = (k == i1) ? p4[k] : g1; g2 = (k == i2) ? p4[k] : g2; }
        const float gs = 1.0f / (g1 + g2); g1 *= gs; g2 *= gs;
        const int e1 = grp * 4 + i1, e2 = grp * 4 + i2;
        unsigned p1 = 0, p2 = 0;
        if (lane == 0) { p1 = __hip_atomic_fetch_add(cnt + e1 * 64, 1u, __ATOMIC_RELAXED, __HIP_MEMORY_SCOPE_AGENT); p2 = __hip_atomic_fetch_add(cnt + e2 * 64, 1u, __ATOMIC_RELAXED, __HIP_MEMORY_SCOPE_AGENT); }
        p1 = __builtin_amdgcn_readfirstlane(p1); p2 = __builtin_amdgcn_readfirstlane(p2);
        const size_t r1 = (size_t)e1 * 8192 + p1, r2 = (size_t)e2 * 8192 + p2;
        if (lane == 0) { DST[r1] = row * 2; DST[r2] = row * 2 + 1; GATE[r1] = g1; GATE[r2] = g2; }
#pragma unroll
        for (int j = 0; j < 8; ++j) { v2u o; o.x = pk2(v[j].x, v[j].y); o.y = pk2(v[j].z, v[j].w);
            *(v2u*)(XS + r1 * 2048 + 4 * lane + 256 * j) = o; *(v2u*)(XS + r2 * 2048 + 4 * lane + 256 * j) = o; }
    }
}
__device__ __forceinline__ void phase_ln_ffn(const Args& args, const Ctx& C0, int layer) {
    const Ctx C = fresh(C0);
    unsigned char* ws = C.ws;
    float* XF = (float*)(ws + WS_XF); const bf16* YB = (const bf16*)(ws + WS_YB); bf16* XB = (bf16*)(ws + WS_XB);
    const float* g = INF(6) + layer * 2048; const float* b = INF(7) + layer * 2048; const int lane = C.lane;
    for (int row = C.gw; row < T; row += C.NGW) {
        f32x4 v[8];
#pragma unroll
        for (int j = 0; j < 8; ++j) { const size_t c = 4 * lane + 256 * j; const f32x4 xv = *(const f32x4*)(XF + (size_t)row * 2048 + c);
            const v2u y0 = *(const v2u*)(YB + (size_t)(2 * row) * 2048 + c), y1 = *(const v2u*)(YB + (size_t)(2 * row + 1) * 2048 + c);
            f32x4 m; m.x = pg8::bf_lo(y0.x) + pg8::bf_lo(y1.x); m.y = pg8::bf_hi(y0.x) + pg8::bf_hi(y1.x); m.z = pg8::bf_lo(y0.y) + pg8::bf_lo(y1.y); m.w = pg8::bf_hi(y0.y) + pg8::bf_hi(y1.y);
            v[j] = xv * DN_ALPHA + m; }
        ln_row(v, g, b, lane);
#pragma unroll
        for (int j = 0; j < 8; ++j) { const size_t c = 4 * lane + 256 * j; *(f32x4*)(XF + (size_t)row * 2048 + c) = v[j];
            v2u o; o.x = pk2(v[j].x, v[j].y); o.y = pk2(v[j].z, v[j].w); *(v2u*)(XB + (size_t)row * 2048 + c) = o;
            if (layer == DEPTH - 1) *(f32x4*)(args.out + (size_t)row * 2048 + c) = v[j]; }
    }
}

__device__ __forceinline__ float ret_log_gamma(int h) { return log1pf(-exp2f(-5.0f - (float)h)); }
__device__ __forceinline__ void nv_even_prep(const Args& args, const Ctx& C0, int li, bool do_vln, bool do_qk) {
    const Ctx C = fresh(C0);
    unsigned char* ws = C.ws; const bf16* H = (const bf16*)(ws + WS_H);
    float* VLN = (float*)(ws + WS_SCR + SC_VLN); float* QR = (float*)(ws + WS_SCR + SC_QR); float* KR = (float*)(ws + WS_SCR + SC_KR);
    const float* lg = INF(12) + li * 1024; const float* lb = INF(13) + li * 1024; const float* cs = (const float*)(ws + WS_COS); const float* sn = (const float*)(ws + WS_SIN);
    if (do_vln) for (int it = C.gw; it < T * 4; it += C.NGW) { const int tok = it >> 2, g = it & 3; const int c0 = g * 256 + 4 * C.lane;
        const v2u w = *(const v2u*)(H + (size_t)tok * HE + 1024 + c0);
        f32x4 v; v.x = pg8::bf_lo(w.x); v.y = pg8::bf_hi(w.x); v.z = pg8::bf_lo(w.y); v.w = pg8::bf_hi(w.y);
        const float mean = wave_sum((v.x + v.y) + (v.z + v.w)) * (1.f / 256.f); v = v - mean;
        const float rstd = 1.0f / sqrtf(wave_sum((v.x * v.x + v.y * v.y) + (v.z * v.z + v.w * v.w)) * (1.f / 256.f) + LN_EPS);
        *(f32x4*)(VLN + (size_t)tok * 1024 + c0) = v * rstd * *(const f32x4*)(lg + c0) + *(const f32x4*)(lb + c0); }
    if (do_qk) for (size_t i = C.gtid; i < (size_t)T * 512; i += C.gsz) { const int tok = (int)(i >> 9), h = (int)((i >> 7) & 3), f = (int)(i & 127);
        const float c = cs[(size_t)tok * 128 + f], s = sn[(size_t)tok * 128 + f]; const bf16* base = H + (size_t)tok * HE;
        const float q1 = bf2f(base[2048 + h * 256 + f]), q2 = bf2f(base[2048 + h * 256 + 128 + f]), k1 = bf2f(base[3072 + h * 256 + f]), k2 = bf2f(base[3072 + h * 256 + 128 + f]);
        QR[(size_t)tok * 1024 + h * 256 + f] = (q1 * c - q2 * s) * 0.0625f; QR[(size_t)tok * 1024 + h * 256 + 128 + f] = (q1 * s + q2 * c) * 0.0625f;
        KR[(size_t)tok * 1024 + h * 256 + f] = k1 * c - k2 * s; KR[(size_t)tok * 1024 + h * 256 + 128 + f] = k1 * s + k2 * c; }
}
__device__ __forceinline__ void nv_even_a(const Args& args, const Ctx& C0, int li, bool do_gate, bool do_ret) {
    const Ctx C = fresh(C0);
    unsigned char* ws = C.ws; const bf16* H = (const bf16*)(ws + WS_H); bf16* YC = (bf16*)(ws + WS_YC);
    const float* VLN = (const float*)(ws + WS_SCR + SC_VLN); const float* QR = (const float*)(ws + WS_SCR + SC_QR); const float* KR = (const float*)(ws + WS_SCR + SC_KR);
    float* SC = (float*)(ws + WS_SCR + SC_SC); float* KV = (float*)(ws + WS_SCR + SC_KV);
    const float* Wsp = INF(14) + (size_t)li * 4 * 128 * 128; const float* Bsp = INF(15) + li * 4 * 128;
    if (do_gate) for (size_t i = C.gtid; i < (size_t)T * 1024; i += C.gsz) { const int tok = (int)(i >> 10), c = (int)(i & 1023), g = c >> 8, ii = tok & 127, blk = tok & ~127;
        const float* wrow = Wsp + ((size_t)g * 128 + ii) * 128; const int jend = (ii >= 64) ? 128 : 64; float s = 0.f;
        for (int j = 0; j < jend; ++j) s += wrow[j] * VLN[(size_t)(blk + j) * 1024 + c];
        s += Bsp[g * 128 + ii];
        YC[(size_t)tok * 2048 + c] = (bf16)f2bf(bf2f(H[(size_t)tok * HE + c]) * s); }
    if (do_ret) for (size_t i = C.gtid; i < (size_t)512 * 4096; i += C.gsz) { const int ch = (int)(i >> 12), ii = (int)((i >> 6) & 63), jj = (int)(i & 63), n = ch & 31, h = (ch >> 5) & 3, b = ch >> 7;
        const float* q = QR + (size_t)(b * 2048 + n * 64 + ii) * 1024 + h * 256; const float* k = KR + (size_t)(b * 2048 + n * 64 + jj) * 1024 + h * 256; float s = 0.f;
        for (int d = 0; d < 256; ++d) s += q[d] * k[d];
        const int dd = ii > jj ? ii - jj : jj - ii; SC[i] = s * expf(ret_log_gamma(h) * (float)dd); }
    if (do_ret) for (size_t i = C.gtid; i < (size_t)512 * 65536; i += C.gsz) { const int ch = (int)(i >> 16), d = (int)((i >> 8) & 255), e = (int)(i & 255), n = ch & 31, h = (ch >> 5) & 3, b = ch >> 7;
        const float lgm = ret_log_gamma(h); const size_t t0 = (size_t)b * 2048 + n * 64; float s = 0.f;
        for (int j = 0; j < 64; ++j) s += KR[(t0 + j) * 1024 + h * 256 + d] * expf(lgm * (float)(63 - j)) * bf2f(H[(t0 + j) * HE + 4096 + h * 256 + e]);
        KV[i] = s; }
}
__device__ __forceinline__ void nv_even_b(const Args& args, const Ctx& C0) {
    const Ctx C = fresh(C0);
    unsigned char* ws = C.ws; const bf16* H = (const bf16*)(ws + WS_H);
    const float* SC = (const float*)(ws + WS_SCR + SC_SC); float* KV = (float*)(ws + WS_SCR + SC_KV); float* OI = (float*)(ws + WS_SCR + SC_OI);
    for (size_t i = C.gtid; i < (size_t)T * 1024; i += C.gsz) { const int tok = (int)(i >> 10), c = (int)(i & 1023), h = c >> 8, b = tok >> 11, n = (tok >> 6) & 31, ii = tok & 63;
        const int ch = (b * 4 + h) * 32 + n; const float* srow = SC + ((size_t)ch * 64 + ii) * 64; const size_t t0 = (size_t)(tok & ~63); float s = 0.f;
        for (int j = 0; j < 64; ++j) s += srow[j] * bf2f(H[(t0 + j) * HE + 4096 + c]);
        OI[i] = s; }
    for (size_t i = C.gtid; i < (size_t)16 * 65536; i += C.gsz) { const int bh = (int)(i >> 16), de = (int)(i & 65535), h = bh & 3;
        const float cd = expf(ret_log_gamma(h) * 64.0f); float st = 0.f;
        for (int n = 0; n < 32; ++n) { float* p = KV + ((size_t)(bh * 32 + n) << 16) + de; const float t = *p; *p = st; st = st * cd + t; } }
}
__device__ __forceinline__ void nv_even_c(const Args& args, const Ctx& C0) {
    const Ctx C = fresh(C0);
    unsigned char* ws = C.ws; const float* QR = (const float*)(ws + WS_SCR + SC_QR); const float* KV = (const float*)(ws + WS_SCR + SC_KV); float* OS = (float*)(ws + WS_SCR + SC_OS);
    for (size_t i = C.gtid; i < (size_t)T * 1024; i += C.gsz) { const int tok = (int)(i >> 10), c = (int)(i & 1023), h = c >> 8, e = c & 255, b = tok >> 11, n = (tok >> 6) & 31, ii = tok & 63;
        const int ch = (b * 4 + h) * 32 + n; const float* q = QR + (size_t)tok * 1024 + h * 256; const float* st = KV + ((size_t)ch << 16) + e; float s = 0.f;
        for (int d = 0; d < 256; ++d) s += q[d] * st[(size_t)d * 256];
        OS[i] = s * expf(ret_log_gamma(h) * (float)(ii + 1)); }
}
__device__ __forceinline__ void phase_even_normgate(const Args& args, const Ctx& C0, int li) {
    const Ctx C = fresh(C0);
    unsigned char* ws = C.ws; const bf16* H = (const bf16*)(ws + WS_H); bf16* YC = (bf16*)(ws + WS_YC);
    const float* OI = (const float*)(ws + WS_SCR + SC_OI); const float* OS = (const float*)(ws + WS_SCR + SC_OS);
    const float* gg = INF(16) + li * 1024; const float* gb = INF(17) + li * 1024;
    for (int it = C.gw; it < T * 4; it += C.NGW) { const int tok = it >> 2, h = it & 3; const int c0 = h * 256 + 4 * C.lane;
        f32x4 v = *(const f32x4*)(OI + (size_t)tok * 1024 + c0) + *(const f32x4*)(OS + (size_t)tok * 1024 + c0);
        const float mean = wave_sum((v.x + v.y) + (v.z + v.w)) * (1.f / 256.f); v = v - mean;
        const float rstd = 1.0f / sqrtf(wave_sum((v.x * v.x + v.y * v.y) + (v.z * v.z + v.w * v.w)) * (1.f / 256.f) + LN_EPS);
        v = v * rstd * *(const f32x4*)(gg + c0) + *(const f32x4*)(gb + c0);
        const v2u gw = *(const v2u*)(H + (size_t)tok * HE + 5120 + c0);
        v2u o; o.x = pk2(silu_f(pg8::bf_lo(gw.x)) * v.x, silu_f(pg8::bf_hi(gw.x)) * v.y); o.y = pk2(silu_f(pg8::bf_lo(gw.y)) * v.z, silu_f(pg8::bf_hi(gw.y)) * v.w);
        *(v2u*)(YC + (size_t)tok * 2048 + 1024 + c0) = o; }
}


typedef short bf16x8 __attribute__((ext_vector_type(8)));
__device__ __forceinline__ bf16x8 lds_frag(const LAS bf16* base, int stride, int row0, int k0, int lane) { return *(const LAS bf16x8*)(base + (row0 + (lane & 15)) * stride + k0 + 8 * (lane >> 4)); }
#define MMA16(a, b, c) __builtin_amdgcn_mfma_f32_16x16x32_bf16((a), (b), (c), 0, 0, 0)
__device__ __forceinline__ v2u pack4(f32x4 v) { v2u o; o.x = pk2(v.x, v.y); o.y = pk2(v.z, v.w); return o; }
__device__ __forceinline__ void unpack8(const v4u w, float (&f)[8]) { f[0] = pg8::bf_lo(w.x); f[1] = pg8::bf_hi(w.x); f[2] = pg8::bf_lo(w.y); f[3] = pg8::bf_hi(w.y); f[4] = pg8::bf_lo(w.z); f[5] = pg8::bf_hi(w.z); f[6] = pg8::bf_lo(w.w); f[7] = pg8::bf_hi(w.w); }

__device__ __forceinline__ void fast_gate_unit(const Args& args, const Ctx& C, int li, int unit) {
    unsigned char* ws = C.ws; const bf16* H = (const bf16*)(ws + WS_H); bf16* YC = (bf16*)(ws + WS_YC);
    LAS bf16* Wm = (LAS bf16*)C.lds;
    LAS bf16* VT = Wm + 128 * 136;
    const int g = unit & 3; const size_t tok0 = (size_t)(unit >> 2) * 128; const int lane = C.lane, w = C.wave;
    const float* Wsp = INF(14) + ((size_t)li * 4 + g) * 128 * 128; const float* Bsp = INF(15) + (li * 4 + g) * 128;
    const float* lg = INF(12) + li * 1024 + g * 256; const float* lb = INF(13) + li * 1024 + g * 256;
    { const int i = C.tid >> 2, j0 = (C.tid & 3) * 32; const float* wrow = Wsp + (size_t)i * 128 + j0; const bool dead = (i < 64) && (j0 >= 64);
#pragma unroll
        for (int q = 0; q < 4; ++q) { f32x4 a = *(const f32x4*)(wrow + 8 * q), b = *(const f32x4*)(wrow + 8 * q + 4); if (dead) { a = (f32x4){0.f, 0.f, 0.f, 0.f}; b = a; }
            v4u o; o.x = pk2(a.x, a.y); o.y = pk2(a.z, a.w); o.z = pk2(b.x, b.y); o.w = pk2(b.z, b.w); *(LAS v4u*)(Wm + i * 136 + j0 + 8 * q) = o; } }
    const f32x4 g4 = *(const f32x4*)(lg + 4 * lane), b4 = *(const f32x4*)(lb + 4 * lane);
#pragma unroll 2
    for (int it = 0; it < 8; ++it) { const int j = 2 * (w + 8 * it); f32x4 nv[2];
#pragma unroll
        for (int r = 0; r < 2; ++r) { const v2u wv = *(const v2u*)(H + (tok0 + j + r) * HE + 1024 + g * 256 + 4 * lane);
            f32x4 v; v.x = pg8::bf_lo(wv.x); v.y = pg8::bf_hi(wv.x); v.z = pg8::bf_lo(wv.y); v.w = pg8::bf_hi(wv.y);
            const float mean = wave_sum((v.x + v.y) + (v.z + v.w)) * (1.f / 256.f); v = v - mean;
            const float rstd = 1.0f / sqrtf(wave_sum((v.x * v.x + v.y * v.y) + (v.z * v.z + v.w * v.w)) * (1.f / 256.f) + LN_EPS);
            nv[r] = v * rstd * g4 + b4; }
#pragma unroll
        for (int q = 0; q < 4; ++q) *(LAS unsigned*)(VT + (4 * lane + q) * 136 + j) = pk2(nv[0][q], nv[1][q]); }
    __syncthreads();
    bf16x8 a[4];
#pragma unroll
    for (int ks = 0; ks < 4; ++ks) a[ks] = lds_frag(Wm, 136, 16 * w, 32 * ks, lane);
    const int i = 16 * w + (lane & 15); const float bi = Bsp[i]; const size_t tok = tok0 + i;
#pragma unroll 4
    for (int nt = 0; nt < 16; ++nt) { f32x4 acc = (f32x4){0.f, 0.f, 0.f, 0.f};
#pragma unroll
        for (int ks = 0; ks < 4; ++ks) acc = MMA16(lds_frag(VT, 136, 16 * nt, 32 * ks, lane), a[ks], acc);
        const int c = g * 256 + 16 * nt + 4 * (lane >> 4); const v2u uw = *(const v2u*)(H + tok * HE + c);
        f32x4 o; o.x = pg8::bf_lo(uw.x) * (acc.x + bi); o.y = pg8::bf_hi(uw.x) * (acc.y + bi); o.z = pg8::bf_lo(uw.y) * (acc.z + bi); o.w = pg8::bf_hi(uw.y) * (acc.w + bi);
        *(v2u*)(YC + tok * 2048 + c) = pack4(o); }
    __syncthreads();
}
__device__ __forceinline__ void fast_ret_intra_unit(const Ctx& C, int unit) {
    unsigned char* ws = C.ws; const bf16* H = (const bf16*)(ws + WS_H); float* OI = (float*)(ws + WS_SCR + SC_OI);
    LAS bf16* Qs = (LAS bf16*)C.lds;
    LAS bf16* Ks = Qs + 64 * 264;
    LAS bf16* VT = Ks + 64 * 264;
    LAS bf16* Sb = VT + 256 * 72;
    const int n = unit & 31, h = (unit >> 5) & 3, b = unit >> 7; const size_t tok0 = (size_t)b * 2048 + n * 64; const int lane = C.lane, w = C.wave;
#pragma unroll
    for (int k = 0; k < 4; ++k) { const int p = C.tid + 512 * k, row = p >> 5, cs = p & 31; const bf16* src = H + (tok0 + row) * HE + h * 256 + cs * 8;
        *(LAS v4u*)(Qs + row * 264 + cs * 8) = *(const v4u*)(src + 2048); *(LAS v4u*)(Ks + row * 264 + cs * 8) = *(const v4u*)(src + 3072);
        const v4u vv = *(const v4u*)(src + 4096); LAS bf16* d = VT + (cs * 8) * 72 + row;
        d[0] = (bf16)(vv.x & 0xffff); d[72] = (bf16)(vv.x >> 16); d[144] = (bf16)(vv.y & 0xffff); d[216] = (bf16)(vv.y >> 16); d[288] = (bf16)(vv.z & 0xffff); d[360] = (bf16)(vv.z >> 16); d[432] = (bf16)(vv.w & 0xffff); d[504] = (bf16)(vv.w >> 16); }
    __syncthreads();
    const float lgm = ret_log_gamma(h);
    { const int mt = w & 3; bf16x8 a[8];
#pragma unroll
        for (int ks = 0; ks < 8; ++ks) a[ks] = lds_frag(Qs, 264, 16 * mt, 32 * ks, lane);
#pragma unroll
        for (int t2 = 0; t2 < 2; ++t2) { const int nt = (w >> 2) * 2 + t2; f32x4 acc = (f32x4){0.f, 0.f, 0.f, 0.f};
#pragma unroll
            for (int ks = 0; ks < 8; ++ks) acc = MMA16(lds_frag(Ks, 264, 16 * nt, 32 * ks, lane), a[ks], acc);
            const int i = 16 * mt + (lane & 15), j0 = 16 * nt + 4 * (lane >> 4);
#pragma unroll
            for (int r = 0; r < 4; ++r) { const int dd = i > j0 + r ? i - (j0 + r) : (j0 + r) - i; acc[r] *= expf(lgm * (float)dd); }
            *(LAS v2u*)(Sb + i * 72 + j0) = pack4(acc); } }
    __syncthreads();
    { const int mt = w & 3; bf16x8 a[2];
#pragma unroll
        for (int ks = 0; ks < 2; ++ks) a[ks] = lds_frag(Sb, 72, 16 * mt, 32 * ks, lane);
        const int i = 16 * mt + (lane & 15);
#pragma unroll 4
        for (int k = 0; k < 8; ++k) { const int nt = (w >> 2) + 2 * k; f32x4 acc = (f32x4){0.f, 0.f, 0.f, 0.f};
#pragma unroll
            for (int ks = 0; ks < 2; ++ks) acc = MMA16(lds_frag(VT, 72, 16 * nt, 32 * ks, lane), a[ks], acc);
            *(f32x4*)(OI + (tok0 + i) * 1024 + h * 256 + 16 * nt + 4 * (lane >> 4)) = acc; } }
    __syncthreads();
}
__device__ __forceinline__ void fast_ret_state_unit(const Ctx& C, int unit) {
    unsigned char* ws = C.ws; const bf16* H = (const bf16*)(ws + WS_H); float* OS = (float*)(ws + WS_SCR + SC_OS);
    LAS bf16* Qs = (LAS bf16*)C.lds;
    LAS bf16* KdT = Qs + 64 * 264;
    LAS bf16* VT = KdT + 256 * 72;
    LAS bf16* StT = VT + 32 * 72;
    const int es = unit & 7, h = (unit >> 3) & 3, b = unit >> 5; const int lane = C.lane, w = C.wave, tid = C.tid;
    const float lgm = ret_log_gamma(h), g64 = expf(lgm * 64.0f);
    for (int i = tid; i < 32 * 264 / 2; i += NTHR) ((LAS unsigned*)StT)[i] = 0u;
    f32x4 st[2][2];
#pragma unroll
    for (int a = 0; a < 2; ++a)
#pragma unroll
        for (int c = 0; c < 2; ++c) st[a][c] = (f32x4){0.f, 0.f, 0.f, 0.f};
    v4u rq[4], rk[4], rv;
    const bf16* hb = H + (size_t)b * 2048 * HE + h * 256;
#define RS_LOAD(nn) do { _Pragma("unroll") for (int k = 0; k < 4; ++k) { const int p = tid + 512 * k, row = p >> 5, cs = p & 31; const bf16* src = hb + (size_t)((nn) * 64 + row) * HE + cs * 8; rq[k] = *(const v4u*)(src + 2048); rk[k] = *(const v4u*)(src + 3072); } \
        { const int row = (tid >> 2) & 63, sg = tid & 3; rv = *(const v4u*)(hb + (size_t)((nn) * 64 + row) * HE + 4096 + es * 32 + sg * 8); } } while (0)
    RS_LOAD(0);
    for (int n = 0; n < 32; ++n) {
#pragma unroll
        for (int k = 0; k < 4; ++k) { const int p = tid + 512 * k, row = p >> 5, cs = p & 31; *(LAS v4u*)(Qs + row * 264 + cs * 8) = rq[k];
            float f[8]; unpack8(rk[k], f); const float dk = expf(lgm * (float)(63 - row)); LAS bf16* d = KdT + (cs * 8) * 72 + row;
#pragma unroll
            for (int q = 0; q < 8; ++q) d[q * 72] = (bf16)f2bf(f[q] * dk); }
        if (tid < 256) { const int row = tid >> 2, sg = tid & 3; LAS bf16* d = VT + (sg * 8) * 72 + row;
            d[0] = (bf16)(rv.x & 0xffff); d[72] = (bf16)(rv.x >> 16); d[144] = (bf16)(rv.y & 0xffff); d[216] = (bf16)(rv.y >> 16); d[288] = (bf16)(rv.z & 0xffff); d[360] = (bf16)(rv.z >> 16); d[432] = (bf16)(rv.w & 0xffff); d[504] = (bf16)(rv.w >> 16); }
        if (n + 1 < 32) RS_LOAD(n + 1);
        __syncthreads();
        { const int mt = w & 3, nt = w >> 2; f32x4 acc = (f32x4){0.f, 0.f, 0.f, 0.f};
#pragma unroll
            for (int ks = 0; ks < 8; ++ks) acc = MMA16(lds_frag(StT, 264, 16 * nt, 32 * ks, lane), lds_frag(Qs, 264, 16 * mt, 32 * ks, lane), acc);
            const int i = 16 * mt + (lane & 15); const float qd = expf(lgm * (float)(i + 1));
            *(f32x4*)(OS + ((size_t)b * 2048 + n * 64 + i) * 1024 + h * 256 + es * 32 + 16 * nt + 4 * (lane >> 4)) = acc * qd; }
#pragma unroll
        for (int a = 0; a < 2; ++a) { const int mt = 2 * w + a; const bf16x8 k0 = lds_frag(KdT, 72, 16 * mt, 0, lane), k1 = lds_frag(KdT, 72, 16 * mt, 32, lane);
#pragma unroll
            for (int c = 0; c < 2; ++c) { f32x4 nw = (f32x4){0.f, 0.f, 0.f, 0.f}; nw = MMA16(k0, lds_frag(VT, 72, 16 * c, 0, lane), nw); nw = MMA16(k1, lds_frag(VT, 72, 16 * c, 32, lane), nw);
                st[a][c] = st[a][c] * g64 + nw; } }
        __syncthreads();
#pragma unroll
        for (int a = 0; a < 2; ++a)
#pragma unroll
            for (int c = 0; c < 2; ++c) *(LAS v2u*)(StT + (16 * c + (lane & 15)) * 264 + 16 * (2 * w + a) + 4 * (lane >> 4)) = pack4(st[a][c]);
    }
#undef RS_LOAD
    __syncthreads();
}
__device__ __forceinline__ void fast_even_mix(const Args& args, const Ctx& C0, int li) {
    const Ctx C = fresh(C0);
#if FAST_RET
    if (C.bid < 128) fast_ret_state_unit(C, C.bid);
#endif
    const int nw = FAST_RET ? C.G - 128 : C.G, me = FAST_RET ? C.bid - 128 : C.bid;
    if (me >= 0) {
#if FAST_GATE
        for (int u = me; u < 256; u += nw) fast_gate_unit(args, C, li, u);
#endif
#if FAST_RET
        for (int u = me; u < 512; u += nw) fast_ret_intra_unit(C, u);
#endif
    }
}


__device__ __forceinline__ void fast_s5_unit(const Args& args, const Ctx& C, int li, int unit) {
    unsigned char* ws = C.ws; const bf16* H = (const bf16*)(ws + WS_H); bf16* YS = (bf16*)(ws + WS_SCR + SC_YS);
    const int b = unit >> 6, g = unit & 63; const int lane = C.lane, w = C.wave, tid = C.tid, q = lane >> 4, cc = lane & 15;
    LAS bf16* Ut = (LAS bf16*)C.lds;
    LAS bf16* BBs = Ut + 4096;
    LAS float* Ef = (LAS float*)(C.lds + 16384);
    LAS float* buL = (LAS float*)(C.lds + 20480 + w * 13312);
    LAS bf16* Xb = (LAS bf16*)(C.lds + 20480 + w * 13312 + 8448);
    const int gp = (li * 64 + g) * 64 + lane;
    const float dt = expf(INF(27)[li * 64 + g]), are = INF(20)[gp], aim = INF(21)[gp];
    const float mag = expf(are * dt), lbr = mag * cosf(aim * dt), lbi = mag * sinf(aim * dt), den = are * are + aim * aim;
    const float fre = ((lbr - 1.0f) * are + lbi * aim) / den, fim = (lbi * are - (lbr - 1.0f) * aim) / den;
    if (w == 0) { const float* pbre = INF(22) + (size_t)gp * 16; const float* pbim = INF(23) + (size_t)gp * 16; float br[16], bi[16];
#pragma unroll
        for (int c4 = 0; c4 < 4; ++c4) { const f32x4 r4 = *(const f32x4*)(pbre + 4 * c4), i4 = *(const f32x4*)(pbim + 4 * c4);
#pragma unroll
            for (int k = 0; k < 4; ++k) { br[4 * c4 + k] = fre * r4[k] - fim * i4[k]; bi[4 * c4 + k] = fre * i4[k] + fim * r4[k]; } }
#pragma unroll
        for (int c8 = 0; c8 < 2; ++c8) { v4u o; o.x = pk2(br[8 * c8], br[8 * c8 + 1]); o.y = pk2(br[8 * c8 + 2], br[8 * c8 + 3]); o.z = pk2(br[8 * c8 + 4], br[8 * c8 + 5]); o.w = pk2(br[8 * c8 + 6], br[8 * c8 + 7]);
            *(LAS v4u*)(BBs + (2 * lane) * 16 + 8 * c8) = o;
            o.x = pk2(bi[8 * c8], bi[8 * c8 + 1]); o.y = pk2(bi[8 * c8 + 2], bi[8 * c8 + 3]); o.z = pk2(bi[8 * c8 + 4], bi[8 * c8 + 5]); o.w = pk2(bi[8 * c8 + 6], bi[8 * c8 + 7]);
            *(LAS v4u*)(BBs + (2 * lane + 1) * 16 + 8 * c8) = o; } }
    float l16r = lbr, l16i = lbi;
#pragma unroll
    for (int k = 0; k < 4; ++k) { const float nr = l16r * l16r - l16i * l16i, ni = 2.0f * l16r * l16i; l16r = nr; l16i = ni; }
    bf16x8 cf[4];
    { const float* pcr = INF(24) + ((size_t)(li * 64 + g) * 16 + cc) * 64; const float* pci = INF(25) + ((size_t)(li * 64 + g) * 16 + cc) * 64;
#pragma unroll
        for (int ks = 0; ks < 4; ++ks) { const f32x4 r4 = *(const f32x4*)(pcr + 16 * ks + 4 * q), i4 = *(const f32x4*)(pci + 16 * ks + 4 * q);
            v4u o; o.x = pk2(r4.x, -i4.x); o.y = pk2(r4.y, -i4.y); o.z = pk2(r4.z, -i4.z); o.w = pk2(r4.w, -i4.w); cf[ks] = __builtin_bit_cast(bf16x8, o); } }
    const float dsk = INF(26)[(li * 64 + g) * 16 + cc];
    __syncthreads();
    bf16x8 bbf[8];
#pragma unroll
    for (int nt = 0; nt < 8; ++nt) { v4u o = (v4u){0u, 0u, 0u, 0u}; if (q < 2) o = *(const LAS v4u*)(BBs + (16 * nt + cc) * 16 + 8 * q); bbf[nt] = __builtin_bit_cast(bf16x8, o); }
    const size_t tokb = (size_t)b * 2048;
    const int lrow = tid >> 2, lpc = tid & 3;
    v2u ureg = *(const v2u*)(H + (tokb + lrow) * HO + g * 16 + 4 * lpc);
    float cr = 0.f, ci = 0.f;
    for (int tile = 0; tile < 16; ++tile) {
        *(LAS v2u*)(Ut + lrow * 16 + 4 * lpc) = ureg;
        if (tile + 1 < 16) ureg = *(const v2u*)(H + (tokb + (tile + 1) * 128 + lrow) * HO + g * 16 + 4 * lpc);
        __syncthreads();
        { v4u ao = (v4u){0u, 0u, 0u, 0u}; if (q < 2) ao = *(const LAS v4u*)(Ut + (16 * w + cc) * 16 + 8 * q); const bf16x8 af = __builtin_bit_cast(bf16x8, ao);
#pragma unroll
            for (int nt = 0; nt < 8; ++nt) { f32x4 acc = (f32x4){0.f, 0.f, 0.f, 0.f}; acc = MMA16(af, bbf[nt], acc);
#pragma unroll
                for (int r = 0; r < 4; ++r) buL[(4 * q + r) * 132 + 16 * nt + cc] = acc[r]; } }
        float ue[4];
#pragma unroll
        for (int r = 0; r < 4; ++r) ue[r] = bf2f(Ut[(16 * w + 4 * q + r) * 16 + cc]);
        LDS_WAIT();
        float xr = 0.f, xi = 0.f;
#pragma unroll
        for (int t = 0; t < 16; ++t) { const f32x2 bu = *(const LAS f32x2*)(buL + t * 132 + 2 * lane);
            const float nr = lbr * xr - lbi * xi + bu.x, ni = lbr * xi + lbi * xr + bu.y; xr = nr; xi = ni;
            *(LAS f32x2*)(buL + t * 132 + 2 * lane) = (f32x2){xr, xi}; }
        *(LAS f32x2*)(Ef + (w * 64 + lane) * 2) = (f32x2){xr, xi};
        __syncthreads();
        float sr = cr, si = ci, mr = 0.f, mi = 0.f;
#pragma unroll
        for (int v = 0; v < 8; ++v) { if (v == w) { mr = sr; mi = si; } const f32x2 e = *(const LAS f32x2*)(Ef + (v * 64 + lane) * 2);
            const float nr = l16r * sr - l16i * si + e.x, ni = l16r * si + l16i * sr + e.y; sr = nr; si = ni; }
        cr = sr; ci = si;
        float pr = lbr, pi = lbi;
#pragma unroll
        for (int t = 0; t < 16; ++t) { const f32x2 xl = *(const LAS f32x2*)(buL + t * 132 + 2 * lane);
            const float x0 = xl.x + pr * mr - pi * mi, x1 = xl.y + pr * mi + pi * mr;
            *(LAS unsigned*)(Xb + t * 136 + 2 * lane) = pk2(x0, x1);
            const float nr = pr * lbr - pi * lbi, ni = pr * lbi + pi * lbr; pr = nr; pi = ni; }
        LDS_WAIT();
        { f32x4 acc = (f32x4){0.f, 0.f, 0.f, 0.f};
#pragma unroll
            for (int ks = 0; ks < 4; ++ks) acc = MMA16(lds_frag(Xb, 136, 0, 32 * ks, lane), cf[ks], acc);
#pragma unroll
            for (int r = 0; r < 4; ++r) { const int t = 16 * w + 4 * q + r; const float s = acc[r] + dsk * ue[r];
                YS[(tokb + tile * 128 + t) * 1024 + g * 16 + cc] = (bf16)f2bf(0.5f * s * (1.0f + erff(s * 0.70710678118654752f))); } }
    }
    __syncthreads();
}


constexpr size_t SC_DUT = 64 * MiB;
constexpr size_t SC_DW = 80 * MiB;
constexpr size_t SC_DAT = 96 * MiB;
constexpr size_t SC_DQD = 104 * MiB;
constexpr size_t SC_DKT = 120 * MiB;
constexpr size_t SC_DGL = 136 * MiB;

__device__ __forceinline__ float oct_sum(float v) {
    v += __builtin_bit_cast(float, __builtin_amdgcn_mov_dpp(__builtin_bit_cast(int, v), 0xB1, 0xF, 0xF, true));
    v += __builtin_bit_cast(float, __builtin_amdgcn_mov_dpp(__builtin_bit_cast(int, v), 0x4E, 0xF, 0xF, true));
    v += __builtin_bit_cast(float, __builtin_amdgcn_mov_dpp(__builtin_bit_cast(int, v), 0x141, 0xF, 0xF, true));
    return v;
}
__device__ __forceinline__ f32x4 prod64(const LAS bf16* A, const LAS bf16* Bt, int mt, int nt, int lane, f32x4 acc) {
#pragma unroll
    for (int ks = 0; ks < 2; ++ks) acc = MMA16(lds_frag(Bt, 72, 16 * nt, 32 * ks, lane), lds_frag(A, 72, 16 * mt, 32 * ks, lane), acc);
    return acc;
}
__device__ __forceinline__ void put_both(f32x4 acc, LAS bf16* Dr, LAS bf16* Dt, int mt, int nt, int lane) {
    const int i = 16 * mt + (lane & 15), j0 = 16 * nt + 4 * (lane >> 4);
    *(LAS v2u*)(Dr + i * 72 + j0) = pack4(acc);
#pragma unroll
    for (int r = 0; r < 4; ++r) Dt[(j0 + r) * 72 + i] = (bf16)f2bf(acc[r]);
}
__device__ __forceinline__ void fast_dn_local_unit(const Args& args, const Ctx& C, int li, int unit) {
    unsigned char* ws = C.ws; const bf16* H = (const bf16*)(ws + WS_H);
    const int tid = C.tid, w = C.wave, lane = C.lane, q = lane >> 4, cc = lane & 15;
    const int n = unit & 31, h = (unit >> 5) & 7, b = unit >> 8;
    LAS bf16* QL = (LAS bf16*)C.lds;
    LAS bf16* Kn = QL + 64 * 136;
    LAS bf16* KB = Kn + 64 * 136;
    LAS bf16* VbT = KB + 64 * 136;
    LAS bf16* KeT = VbT + 128 * 72;
    LAS bf16* X0 = KeT + 128 * 72;
    LAS bf16* X1 = X0 + 64 * 72;
    LAS bf16* X2 = X1 + 64 * 72;
    LAS float* gs = (LAS float*)(X2 + 64 * 72);
    LAS float* eg = gs + 64;
    LAS bf16* B0 = QL; LAS bf16* B1 = B0 + 64 * 72; LAS bf16* B2 = B1 + 64 * 72; LAS bf16* B3 = B2 + 64 * 72; LAS bf16* B4 = B3 + 64 * 72;
    const size_t tok0 = (size_t)b * 2048 + n * 64;
    const float* cw = INF(30) + (size_t)li * 4 * 3072;
    const int r = tid >> 3, cs = tid & 7; const size_t tok = tok0 + r; const int tp = n * 64 + r;
    const float braw = bf2f(H[tok * HO + 5120 + h]), araw = bf2f(H[tok * HO + 5128 + h]);
    const float beta = 1.0f / (1.0f + expf(-braw)); const float zz = araw + INF(32)[li * 8 + h]; const float gval = -expf(INF(31)[li * 8 + h]) * ((zz > 20.f) ? zz : log1pf(expf(zz)));
    if (cs == 0) gs[r] = gval;
    v4u qpk[2], kpk[2];
#pragma unroll 1
    for (int s = 0; s < 3; ++s) { const int chb = s * 1024 + h * 128 + 16 * cs; float acc[16];
#pragma unroll
        for (int i = 0; i < 16; ++i) acc[i] = 0.f;
#pragma unroll
        for (int k = 0; k < 4; ++k) { if (tp - 3 + k >= 0) { const bf16* xr = H + (tok - 3 + k) * HO + 1024 + chb; const float* wk = cw + k * 3072 + chb;
#pragma unroll
                for (int p = 0; p < 2; ++p) { float f[8]; unpack8(*(const v4u*)(xr + 8 * p), f); const f32x4 w0 = *(const f32x4*)(wk + 8 * p), w1 = *(const f32x4*)(wk + 8 * p + 4);
                    acc[8 * p] += w0.x * f[0]; acc[8 * p + 1] += w0.y * f[1]; acc[8 * p + 2] += w0.z * f[2]; acc[8 * p + 3] += w0.w * f[3];
                    acc[8 * p + 4] += w1.x * f[4]; acc[8 * p + 5] += w1.y * f[5]; acc[8 * p + 6] += w1.z * f[6]; acc[8 * p + 7] += w1.w * f[7]; } } }
        float ss = 0.f;
#pragma unroll
        for (int i = 0; i < 16; ++i) { acc[i] = silu_f(acc[i]); ss += acc[i] * acc[i]; }
        if (s < 2) { ss = oct_sum(ss); float sc = 1.0f / sqrtf(ss + RMS_EPS); if (s == 0) sc *= 0.08838834764831845f;
            LAS bf16* dst = (s == 0) ? QL : Kn;
#pragma unroll
            for (int p = 0; p < 2; ++p) { v4u o; o.x = pk2(acc[8 * p] * sc, acc[8 * p + 1] * sc); o.y = pk2(acc[8 * p + 2] * sc, acc[8 * p + 3] * sc); o.z = pk2(acc[8 * p + 4] * sc, acc[8 * p + 5] * sc); o.w = pk2(acc[8 * p + 6] * sc, acc[8 * p + 7] * sc);
                *(LAS v4u*)(dst + r * 136 + 16 * cs + 8 * p) = o;
                if (s == 0) qpk[p] = o;
                else { const float sb = sc * beta; v4u o2; o2.x = pk2(acc[8 * p] * sb, acc[8 * p + 1] * sb); o2.y = pk2(acc[8 * p + 2] * sb, acc[8 * p + 3] * sb); o2.z = pk2(acc[8 * p + 4] * sb, acc[8 * p + 5] * sb); o2.w = pk2(acc[8 * p + 6] * sb, acc[8 * p + 7] * sb);
                    *(LAS v4u*)(KB + r * 136 + 16 * cs + 8 * p) = o2; kpk[p] = o2; } }
        } else {
#pragma unroll
            for (int i = 0; i < 16; ++i) VbT[(16 * cs + i) * 72 + r] = (bf16)f2bf(acc[i] * beta);
        } }
    __syncthreads();
    if (w == 0) { float v = gs[lane];
#pragma unroll
        for (int d = 1; d < 64; d <<= 1) { gs[lane] = v; LDS_WAIT(); const float o = gs[lane >= d ? lane - d : lane]; LDS_WAIT(); if (lane >= d) v += o; }
        gs[lane] = v; eg[lane] = expf(v); }
    __syncthreads();
    const float glast = gs[63];
    { const float e = eg[r]; bf16* DQD = (bf16*)(ws + WS_SCR + SC_DQD) + (size_t)unit * 8192;
#pragma unroll
        for (int p = 0; p < 2; ++p) { float f[8]; unpack8(kpk[p], f);
#pragma unroll
            for (int k = 0; k < 8; ++k) KeT[(16 * cs + 8 * p + k) * 72 + r] = (bf16)f2bf(f[k] * e);
            unpack8(qpk[p], f); v4u o; o.x = pk2(f[0] * e, f[1] * e); o.y = pk2(f[2] * e, f[3] * e); o.z = pk2(f[4] * e, f[5] * e); o.w = pk2(f[6] * e, f[7] * e); *(v4u*)(DQD + r * 128 + 16 * cs + 8 * p) = o; } }
    { const int d = tid >> 2, jq = tid & 3; bf16* DKT = (bf16*)(ws + WS_SCR + SC_DKT) + (size_t)unit * 8192;
#pragma unroll
        for (int p = 0; p < 2; ++p) { float f[8];
#pragma unroll
            for (int k = 0; k < 8; ++k) { const int j = 16 * jq + 8 * p + k; f[k] = bf2f(Kn[j * 136 + d]) * expf(glast - gs[j]); }
            v4u o; o.x = pk2(f[0], f[1]); o.y = pk2(f[2], f[3]); o.z = pk2(f[4], f[5]); o.w = pk2(f[6], f[7]); *(v4u*)(DKT + d * 64 + 16 * jq + 8 * p) = o; } }
    if (tid == 0) ((float*)(ws + WS_SCR + SC_DGL))[unit] = expf(glast);
    const int mt = w & 3, nt0 = (w >> 2) * 2;
    f32x4 Tacc[2];
    { bf16x8 ak[4], aq[4]; bf16* DAT = (bf16*)(ws + WS_SCR + SC_DAT) + (size_t)unit * 4096;
#pragma unroll
        for (int ks = 0; ks < 4; ++ks) { ak[ks] = lds_frag(KB, 136, 16 * mt, 32 * ks, lane); aq[ks] = lds_frag(QL, 136, 16 * mt, 32 * ks, lane); }
        const int i = 16 * mt + cc; const float gci = gs[i];
#pragma unroll
        for (int t2 = 0; t2 < 2; ++t2) { const int nt = nt0 + t2; f32x4 la = (f32x4){0.f, 0.f, 0.f, 0.f}, aa = la;
            if (nt <= mt) {
#pragma unroll
                for (int ks = 0; ks < 4; ++ks) { const bf16x8 bk = lds_frag(Kn, 136, 16 * nt, 32 * ks, lane); la = MMA16(bk, ak[ks], la); aa = MMA16(bk, aq[ks], aa); }
                const f32x4 gcj = *(const LAS f32x4*)(gs + 16 * nt + 4 * q);
#pragma unroll
                for (int rr = 0; rr < 4; ++rr) { const int j = 16 * nt + 4 * q + rr; const float dec = expf(gci - gcj[rr]); la[rr] = (i > j) ? la[rr] * dec : 0.f; aa[rr] = (i >= j) ? aa[rr] * dec : 0.f; } }
            *(v2u*)(DAT + i * 64 + 16 * nt + 4 * q) = pack4(aa);
            put_both(la, X0, X1, mt, nt, lane);
            f32x4 t0;
#pragma unroll
            for (int rr = 0; rr < 4; ++rr) t0[rr] = ((i == 16 * nt + 4 * q + rr) ? 1.0f : 0.0f) - la[rr];
            Tacc[t2] = t0; *(LAS v2u*)(X2 + i * 72 + 16 * nt + 4 * q) = pack4(t0); } }
    __syncthreads();
#pragma unroll
    for (int t2 = 0; t2 < 2; ++t2) put_both(prod64(X0, X1, mt, nt0 + t2, lane, (f32x4){0.f, 0.f, 0.f, 0.f}), B0, B1, mt, nt0 + t2, lane);
    __syncthreads();
#define DN_STEP(Tin, Sr, St, Tout, Sr2, St2, LAST) do { _Pragma("unroll") for (int t2 = 0; t2 < 2; ++t2) { Tacc[t2] = prod64(Tin, St, mt, nt0 + t2, lane, Tacc[t2]); \
            *(LAS v2u*)(Tout + (16 * mt + cc) * 72 + 16 * (nt0 + t2) + 4 * q) = pack4(Tacc[t2]); \
            if (!(LAST)) put_both(prod64(Sr, St, mt, nt0 + t2, lane, (f32x4){0.f, 0.f, 0.f, 0.f}), Sr2, St2, mt, nt0 + t2, lane); } __syncthreads(); } while (0)
    DN_STEP(X2, B0, B1, B2, B3, B4, false);
    DN_STEP(B2, B3, B4, X2, B0, B1, false);
    DN_STEP(X2, B0, B1, B2, B3, B4, false);
    DN_STEP(B2, B3, B4, X2, B0, B1, false);
    DN_STEP(X2, B0, B1, B2, B3, B4, true);
#undef DN_STEP
    { bf16* DUT = (bf16*)(ws + WS_SCR + SC_DUT) + (size_t)unit * 8192; bf16* DW = (bf16*)(ws + WS_SCR + SC_DW) + (size_t)unit * 8192;
        const bf16x8 a0 = lds_frag(B2, 72, 16 * mt, 0, lane), a1 = lds_frag(B2, 72, 16 * mt, 32, lane);
#pragma unroll
        for (int k = 0; k < 4; ++k) { const int nt = (w >> 2) + 2 * k;
            f32x4 ua = (f32x4){0.f, 0.f, 0.f, 0.f}, wa = ua;
            ua = MMA16(a0, lds_frag(VbT, 72, 16 * nt, 0, lane), ua); ua = MMA16(a1, lds_frag(VbT, 72, 16 * nt, 32, lane), ua);
            wa = MMA16(lds_frag(KeT, 72, 16 * nt, 0, lane), a0, wa); wa = MMA16(lds_frag(KeT, 72, 16 * nt, 32, lane), a1, wa);
            *(v2u*)(DUT + (16 * nt + cc) * 64 + 16 * mt + 4 * q) = pack4(ua);
            *(v2u*)(DW + (16 * mt + cc) * 128 + 16 * nt + 4 * q) = pack4(wa); } }
    __syncthreads();
}
__device__ __forceinline__ void fast_dn_state_unit(const Ctx& C, int unit) {
    unsigned char* ws = C.ws; float* DOo = (float*)(ws + WS_SCR + SC_DO);
    const int es = unit & 3, h = (unit >> 2) & 7, b = unit >> 5; const int lane = C.lane, w = C.wave, tid = C.tid, q = lane >> 4, cc = lane & 15;
    LAS bf16* Ws = (LAS bf16*)C.lds;
    LAS bf16* Qs = Ws + 64 * 136;
    LAS bf16* Ks = Qs + 64 * 136;
    LAS bf16* As = Ks + 128 * 72;
    LAS bf16* StT = As + 64 * 72;
    LAS bf16* VnT = StT + 32 * 136;
    const int u0 = (b * 8 + h) * 32;
    const bf16* DUT = (const bf16*)(ws + WS_SCR + SC_DUT); const bf16* DW = (const bf16*)(ws + WS_SCR + SC_DW); const bf16* DAT = (const bf16*)(ws + WS_SCR + SC_DAT);
    const bf16* DQD = (const bf16*)(ws + WS_SCR + SC_DQD); const bf16* DKT = (const bf16*)(ws + WS_SCR + SC_DKT); const float* DGL = (const float*)(ws + WS_SCR + SC_DGL);
    for (int i = tid; i < 32 * 136 / 2; i += NTHR) ((LAS unsigned*)StT)[i] = 0u;
    f32x4 st[2]; st[0] = (f32x4){0.f, 0.f, 0.f, 0.f}; st[1] = st[0];
    const int mt = w & 3, nt = w >> 2;
    v4u rw[2], rqd[2], rk[2], ra; v2u ru; float gl;
#define DS_LOAD(nn) do { const size_t un = (size_t)(u0 + (nn)); _Pragma("unroll") for (int k = 0; k < 2; ++k) { const int p = tid + 512 * k; rw[k] = *(const v4u*)(DW + un * 8192 + 8 * p); rqd[k] = *(const v4u*)(DQD + un * 8192 + 8 * p); rk[k] = *(const v4u*)(DKT + un * 8192 + 8 * p); } \
        ra = *(const v4u*)(DAT + un * 4096 + 8 * tid); ru = *(const v2u*)(DUT + un * 8192 + (size_t)(es * 32 + 16 * nt + cc) * 64 + 16 * mt + 4 * q); gl = DGL[un]; } while (0)
    DS_LOAD(0);
    for (int n = 0; n < 32; ++n) {
#pragma unroll
        for (int k = 0; k < 2; ++k) { const int p = tid + 512 * k; *(LAS v4u*)(Ws + (p >> 4) * 136 + (p & 15) * 8) = rw[k]; *(LAS v4u*)(Qs + (p >> 4) * 136 + (p & 15) * 8) = rqd[k]; *(LAS v4u*)(Ks + (p >> 3) * 72 + (p & 7) * 8) = rk[k]; }
        *(LAS v4u*)(As + (tid >> 3) * 72 + (tid & 7) * 8) = ra;
        const v2u uu = ru; const float gcur = gl;
        if (n + 1 < 32) DS_LOAD(n + 1);
        __syncthreads();
        f32x4 pa = (f32x4){0.f, 0.f, 0.f, 0.f}, oa = pa;
#pragma unroll
        for (int ks = 0; ks < 4; ++ks) { const bf16x8 sf = lds_frag(StT, 136, 16 * nt, 32 * ks, lane); pa = MMA16(lds_frag(Ws, 136, 16 * mt, 32 * ks, lane), sf, pa); oa = MMA16(lds_frag(Qs, 136, 16 * mt, 32 * ks, lane), sf, oa); }
        { f32x4 vn; vn.x = pg8::bf_lo(uu.x) - pa.x; vn.y = pg8::bf_hi(uu.x) - pa.y; vn.z = pg8::bf_lo(uu.y) - pa.z; vn.w = pg8::bf_hi(uu.y) - pa.w;
            *(LAS v2u*)(VnT + (16 * nt + cc) * 72 + 16 * mt + 4 * q) = pack4(vn); }
        __syncthreads();
#pragma unroll
        for (int ks = 0; ks < 2; ++ks) oa = MMA16(lds_frag(As, 72, 16 * mt, 32 * ks, lane), lds_frag(VnT, 72, 16 * nt, 32 * ks, lane), oa);
        { float* op = DOo + ((size_t)b * 2048 + n * 64 + 16 * mt + 4 * q) * 1024 + h * 128 + es * 32 + 16 * nt + cc;
#pragma unroll
            for (int rr = 0; rr < 4; ++rr) op[(size_t)rr * 1024] = oa[rr]; }
#pragma unroll
        for (int c = 0; c < 2; ++c) { f32x4 nw = (f32x4){0.f, 0.f, 0.f, 0.f};
#pragma unroll
            for (int ks = 0; ks < 2; ++ks) nw = MMA16(lds_frag(Ks, 72, 16 * w, 32 * ks, lane), lds_frag(VnT, 72, 16 * c, 32 * ks, lane), nw);
            st[c] = st[c] * gcur + nw; }
        __syncthreads();
#pragma unroll
        for (int c = 0; c < 2; ++c) *(LAS v2u*)(StT + (16 * c + cc) * 136 + 16 * w + 4 * q) = pack4(st[c]);
    }
#undef DS_LOAD
    __syncthreads();
}
__device__ __forceinline__ void fast_odd_mix_a(const Args& args, const Ctx& C0, int li) {
    const Ctx C = fresh(C0);
    for (int u = C.bid; u < 1024; u += C.G) fast_dn_local_unit(args, C, li, u);
}

__device__ __forceinline__ void fast_odd_mix_b(const Args& args, const Ctx& C0, int li) {
    const Ctx C = fresh(C0);
    const int first = FAST_DN ? 128 : 32, nw = C.G - first, me = C.bid - first;
#if FAST_DN
    if (C.bid < 128) fast_dn_state_unit(C, C.bid);
#endif
#if FAST_S5
    if (me >= 0) for (int u = me; u < 256; u += nw) fast_s5_unit(args, C, li, u);
#endif
}

__device__ __forceinline__ void nv_odd_a(const Args& args, const Ctx& C0, int li, bool do_s5, bool do_dn) {
    const Ctx C = fresh(C0);
    unsigned char* ws = C.ws; const bf16* H = (const bf16*)(ws + WS_H); f32x2* X5 = (f32x2*)(ws + WS_SCR + SC_X5);
    const int lane = C.lane;
    if (do_s5) for (int it = C.gw; it < 256; it += C.NGW) { const int b = it >> 6, g = it & 63; const int gp = (li * 64 + g) * 64 + lane;
        const float dt = expf(INF(27)[li * 64 + g]), are = INF(20)[gp], aim = INF(21)[gp]; const float* pbre = INF(22); const float* pbim = INF(23);
        const float mag = expf(are * dt), lbr = mag * cosf(aim * dt), lbi = mag * sinf(aim * dt), den = are * are + aim * aim;
        const float fre = ((lbr - 1.0f) * are + lbi * aim) / den, fim = (lbi * are - (lbr - 1.0f) * aim) / den;
        float bbr[16], bbi[16];
#pragma unroll
        for (int c = 0; c < 16; ++c) { const float br = pbre[(size_t)gp * 16 + c], bi = pbim[(size_t)gp * 16 + c]; bbr[c] = fre * br - fim * bi; bbi[c] = fre * bi + fim * br; }
        float xr = 0.f, xi = 0.f;
        for (int t = 0; t < SEQ; ++t) { const size_t tok = (size_t)b * 2048 + t; const v4u u0 = *(const v4u*)(H + tok * HO + g * 16), u1 = *(const v4u*)(H + tok * HO + g * 16 + 8);
            float u[16]; u[0] = pg8::bf_lo(u0.x); u[1] = pg8::bf_hi(u0.x); u[2] = pg8::bf_lo(u0.y); u[3] = pg8::bf_hi(u0.y); u[4] = pg8::bf_lo(u0.z); u[5] = pg8::bf_hi(u0.z); u[6] = pg8::bf_lo(u0.w); u[7] = pg8::bf_hi(u0.w);
            u[8] = pg8::bf_lo(u1.x); u[9] = pg8::bf_hi(u1.x); u[10] = pg8::bf_lo(u1.y); u[11] = pg8::bf_hi(u1.y); u[12] = pg8::bf_lo(u1.z); u[13] = pg8::bf_hi(u1.z); u[14] = pg8::bf_lo(u1.w); u[15] = pg8::bf_hi(u1.w);
            float br = 0.f, bi = 0.f;
#pragma unroll
            for (int c = 0; c < 16; ++c) { br += bbr[c] * u[c]; bi += bbi[c] * u[c]; }
            const float nr = lbr * xr - lbi * xi + br, ni = lbr * xi + lbi * xr + bi; xr = nr; xi = ni;
            X5[(tok * 64 + g) * 64 + lane] = (f32x2){xr, xi}; } }
    float* QN = (float*)(ws + WS_SCR + SC_QN); float* KN = (float*)(ws + WS_SCR + SC_KN); float* VN = (float*)(ws + WS_SCR + SC_VN);
    float* BETA = (float*)(ws + WS_SCR + SC_BETA); float* GG = (float*)(ws + WS_SCR + SC_G);
    const float* cw = INF(30) + (size_t)li * 4 * 3072; const float* pdtb = INF(32); const float* palog = INF(31);
    if (do_dn) for (int it = C.gw; it < T * 8; it += C.NGW) { const int tok = it >> 3, h = it & 7, tp = tok & 2047; float val[3][2];
#pragma unroll
        for (int s = 0; s < 3; ++s) { const int ch = s * 1024 + h * 128 + 2 * lane; float a0 = 0.f, a1 = 0.f;
#pragma unroll
            for (int k = 0; k < 4; ++k) { const int tt = tp - 3 + k; if (tt >= 0) { const unsigned w = *(const unsigned*)(H + (size_t)(tok - 3 + k) * HO + 1024 + ch); a0 += cw[k * 3072 + ch] * pg8::bf_lo(w); a1 += cw[k * 3072 + ch + 1] * pg8::bf_hi(w); } }
            val[s][0] = silu_f(a0); val[s][1] = silu_f(a1); }
        const float qn = 1.0f / sqrtf(wave_sum(val[0][0] * val[0][0] + val[0][1] * val[0][1]) + RMS_EPS) * 0.08838834764831845f;
        const float kn = 1.0f / sqrtf(wave_sum(val[1][0] * val[1][0] + val[1][1] * val[1][1]) + RMS_EPS);
        const size_t o = (size_t)tok * 1024 + h * 128 + 2 * lane;
        *(f32x2*)(QN + o) = (f32x2){val[0][0] * qn, val[0][1] * qn}; *(f32x2*)(KN + o) = (f32x2){val[1][0] * kn, val[1][1] * kn}; *(f32x2*)(VN + o) = (f32x2){val[2][0], val[2][1]};
        if (lane == 0) { const float braw = bf2f(H[(size_t)tok * HO + 5120 + h]), araw = bf2f(H[(size_t)tok * HO + 5128 + h]);
            BETA[tok * 8 + h] = 1.0f / (1.0f + expf(-braw));
            const float z = araw + pdtb[li * 8 + h]; const float sp = (z > 20.f) ? z : log1pf(expf(z));
            GG[tok * 8 + h] = -expf(palog[li * 8 + h]) * sp; } }
}
__device__ __forceinline__ void nv_odd_b(const Args& args, const Ctx& C0, int li, bool do_s5, bool do_dn) {
    const Ctx C = fresh(C0);
    unsigned char* ws = C.ws; const bf16* H = (const bf16*)(ws + WS_H); const f32x2* X5 = (const f32x2*)(ws + WS_SCR + SC_X5); bf16* YS = (bf16*)(ws + WS_SCR + SC_YS);
    const float* QN = (const float*)(ws + WS_SCR + SC_QN); const float* KN = (const float*)(ws + WS_SCR + SC_KN); const float* VN = (const float*)(ws + WS_SCR + SC_VN);
    const float* BETA = (const float*)(ws + WS_SCR + SC_BETA); const float* GG = (const float*)(ws + WS_SCR + SC_G); float* DOo = (float*)(ws + WS_SCR + SC_DO);
    if (C.bid < 32) { if (do_dn) { const int bh = C.bid, b = bh >> 3, h = bh & 7, e = C.tid >> 2, dq = C.tid & 3;
        float S[32];
#pragma unroll
        for (int d = 0; d < 32; ++d) S[d] = 0.f;
        for (int t = 0; t < SEQ; ++t) { const size_t tok = (size_t)b * 2048 + t; const float* k = KN + tok * 1024 + h * 128 + dq * 32; const float* q = QN + tok * 1024 + h * 128 + dq * 32;
            const float a = expf(GG[tok * 8 + h]), bt = BETA[tok * 8 + h], ve = VN[tok * 1024 + h * 128 + e];
            f32x4 kk[8];
#pragma unroll
            for (int d4 = 0; d4 < 8; ++d4) kk[d4] = *(const f32x4*)(k + 4 * d4);
            float dot = 0.f;
#pragma unroll
            for (int d4 = 0; d4 < 8; ++d4) dot += kk[d4].x * S[4 * d4] + kk[d4].y * S[4 * d4 + 1] + kk[d4].z * S[4 * d4 + 2] + kk[d4].w * S[4 * d4 + 3];
            dot = quad_sum(dot);
            const float c2 = bt * (ve - a * dot); float o = 0.f;
#pragma unroll
            for (int d4 = 0; d4 < 8; ++d4) { const f32x4 qq = *(const f32x4*)(q + 4 * d4);
                S[4 * d4] = a * S[4 * d4] + kk[d4].x * c2; S[4 * d4 + 1] = a * S[4 * d4 + 1] + kk[d4].y * c2; S[4 * d4 + 2] = a * S[4 * d4 + 2] + kk[d4].z * c2; S[4 * d4 + 3] = a * S[4 * d4 + 3] + kk[d4].w * c2;
                o += qq.x * S[4 * d4] + qq.y * S[4 * d4 + 1] + qq.z * S[4 * d4 + 2] + qq.w * S[4 * d4 + 3]; }
            o = quad_sum(o);
            if (dq == 0) DOo[tok * 1024 + h * 128 + e] = o; } } }
    else if (do_s5) { const size_t g0 = (size_t)(C.bid - 32) * NTHR + C.tid, gs = (size_t)(C.G - 32) * NTHR;
        const float* pcr = INF(24); const float* pci = INF(25); const float* pcd = INF(26);
        for (size_t i = g0; i < (size_t)T * 1024; i += gs) { const int tok = (int)(i >> 10), c = (int)(i & 1023), g = c >> 4, cc = c & 15;
            const f32x2* x = X5 + ((size_t)tok * 64 + g) * 64; const float* cr = pcr + ((size_t)(li * 64 + g) * 16 + cc) * 64; const float* ci = pci + ((size_t)(li * 64 + g) * 16 + cc) * 64; float s = 0.f;
            for (int p = 0; p < 64; ++p) { const f32x2 xv = x[p]; s += xv.x * cr[p] - xv.y * ci[p]; }
            s += pcd[(li * 64 + g) * 16 + cc] * bf2f(H[(size_t)tok * HO + c]);
            YS[i] = (bf16)f2bf(0.5f * s * (1.0f + erff(s * 0.70710678118654752f))); } }
}
__device__ __forceinline__ void phase_odd_normgate(const Args& args, const Ctx& C0, int li) {
    const Ctx C = fresh(C0);
    unsigned char* ws = C.ws; const bf16* H = (const bf16*)(ws + WS_H); bf16* YC = (bf16*)(ws + WS_YC); const float* DOo = (const float*)(ws + WS_SCR + SC_DO);
    const float* ng = INF(33) + li * 128;
    for (int it = C.gw; it < T * 8; it += C.NGW) { const int tok = it >> 3, h = it & 7; const int c0 = h * 128 + 2 * C.lane;
        const f32x2 v = *(const f32x2*)(DOo + (size_t)tok * 1024 + c0);
        const float r = 1.0f / sqrtf(wave_sum(v.x * v.x + v.y * v.y) * (1.f / 128.f) + RMS_EPS);
        const unsigned gw = *(const unsigned*)(H + (size_t)tok * HO + 4096 + c0);
        *(unsigned*)(YC + (size_t)tok * 2048 + 1024 + c0) = pk2(v.x * r * ng[2 * C.lane] * silu_f(pg8::bf_lo(gw)), v.y * r * ng[2 * C.lane + 1] * silu_f(pg8::bf_hi(gw))); }
}

__host__ __device__ constexpr bool slot_active(int layer, int slot) {
    const bool odd = layer & 1;
    if (slot == 0 || (slot >= 9 && slot <= 14)) return true;
    if (!odd) { if (slot == 1) return !(FAST_GATE && FAST_RET); if (slot == 2) return true; return (slot == 3 || slot == 4) && !FAST_RET; }
    return slot >= 1 && slot <= 2;
}
constexpr int PH_END = 1 + 16 * DEPTH;
#ifdef TEST_SITE
#define SITE_ON(n) (TEST_SITE == (n))
#else
#define SITE_ON(n) 1
#endif

__global__ void __launch_bounds__(NTHR, 2) trunk_fwd(Args args) {
    extern __shared__ __attribute__((aligned(16))) unsigned char lds_raw[];
    Ctx C;
    C.lds = (LAS unsigned char*)lds_raw; C.tid = threadIdx.x; C.lane = C.tid & 63; C.wave = __builtin_amdgcn_readfirstlane(C.tid >> 6); C.G = gridDim.x;
    C.bid = blockIdx.x; C.gw = blockIdx.x * NWAVES + C.wave; C.NGW = C.G * NWAVES; C.gtid = (size_t)blockIdx.x * NTHR + C.tid; C.gsz = (size_t)C.G * NTHR;
    volatile LAS unsigned* MISC = (volatile LAS unsigned*)(C.lds + MISC_OFF);
    if (C.tid < 64) MISC[C.tid] = 0u;
    __syncthreads();
    C.ws = args.ws;
    unsigned* ctl = (unsigned*)(args.ws + WS_CTL);
    const int lo = args.ph_lo, hi = args.ph_hi; const bool fused = (hi - lo) > 1;
    XcdBarrier bar; bar.bar = ctl + CW_BAR; bar.x = 0; bar.st = nullptr;
    if (fused) bar = xcd_barrier_post(ctl + CW_BAR, MISC);
#define RUN(k) (lo <= (k) && (k) < hi)
#define RUNS(slot) (RUN(base + (slot)) && slot_active(layer, (slot)))
#define SEAM(k) do { if (fused && (k) + 1 < PH_END - 1) xcd_barrier(bar); } while (0)

    #if SITE_ON(0)
        if (RUN(0)) { phase_prologue(args, C); __syncthreads(); SEAM(0); }
#endif


    for (int layer = 0; layer < DEPTH; ++layer) {
        const int base = 1 + 16 * layer, li = layer >> 1; const bool odd = layer & 1;
#define WSL(name) unsigned long long name##_z = 0ull; asm volatile("" : "+s"(name##_z)); unsigned char* name = args.ws + name##_z
        #if SITE_ON(1)
        if (RUNS(0)) { WSL(ws);
            pg8::StaticOrder S; S.init(ws + WS_XB, odd ? (ws + WS_WIO + li * SZ_WIO) : (ws + WS_WIE + li * SZ_WIE), 2048, 32, odd ? 21 : 24, C.G, (int)blockIdx.x);
            pg8::EpiWin E{(bf16*)(ws + WS_H), odd ? HO : HE, odd ? 0 : 8, 0, (!odd && FAST_RET) ? 16 : 0, 12, (const float*)(ws + WS_COS), (const float*)(ws + WS_SIN)};
            if (!odd && FAST_RET) E.rot_lo = 8;
            pg8::gemm_phase<pg8::EpiWin, pg8::StaticOrder, true, true>(C.lds, 2048, S, E);
            SEAM(base + 0);
        }
#endif

        if (!odd) {
            #if SITE_ON(2)
        if (RUNS(1)) { nv_even_prep(args, C, li, !FAST_GATE, !FAST_RET); SEAM(base + 1); }
#endif

            #if SITE_ON(3)
        if (RUNS(2)) { if (!(FAST_GATE && FAST_RET)) nv_even_a(args, C, li, !FAST_GATE, !FAST_RET); if (FAST_GATE || FAST_RET) fast_even_mix(args, C, li); SEAM(base + 2); }
#endif

            #if SITE_ON(4)
        if (RUNS(3)) { nv_even_b(args, C); SEAM(base + 3); }
#endif

            #if SITE_ON(5)
        if (RUNS(4)) { nv_even_c(args, C); SEAM(base + 4); }
#endif

        } else {
            #if SITE_ON(6)
        if (RUNS(1)) { if (!(FAST_S5 && FAST_DN)) nv_odd_a(args, C, li, !FAST_S5, !FAST_DN); if (FAST_DN) fast_odd_mix_a(args, C, li); SEAM(base + 1); }
#endif

            #if SITE_ON(7)
        if (RUNS(2)) { if (!(FAST_S5 && FAST_DN)) nv_odd_b(args, C, li, !FAST_S5, !FAST_DN); if (FAST_S5 || FAST_DN) fast_odd_mix_b(args, C, li); SEAM(base + 2); }
#endif

        }
        #if SITE_ON(8)
        if (RUNS(9)) { WSL(ws);
            if (!odd) phase_even_normgate(args, C, li);
            else {
                pg8::StaticOrder S; S.init(ws + WS_SCR + SC_YS, ws + WS_WGL + li * SZ_WGL, 1024, 32, 4, C.G, (int)blockIdx.x);
                pg8::EpiGlu E{(const bf16*)(ws + WS_SCR + SC_YS), INF(29) + li * 1024, (bf16*)(ws + WS_YC)};
                pg8::gemm_phase<pg8::EpiGlu, pg8::StaticOrder, true, true>(C.lds, 1024, S, E);
                phase_odd_normgate(args, C, li);
            }
            SEAM(base + 9);
        }
#endif

        #if SITE_ON(9)
        if (RUNS(10)) { WSL(ws);
            pg8::StaticOrder S; S.init(ws + WS_YC, odd ? (ws + WS_WOO + li * SZ_WO) : (ws + WS_WOE + li * SZ_WO), 2048, 32, 8, C.G, (int)blockIdx.x);
            pg8::EpiWout E{layer == 0 ? INF(0) : (const float*)(ws + WS_XF), (float*)(ws + WS_Z), DN_ALPHA};
            pg8::gemm_phase<pg8::EpiWout, pg8::StaticOrder, true, true>(C.lds, 2048, S, E);
            SEAM(base + 10);
        }
#endif

        #if SITE_ON(10)
        if (RUNS(11)) { phase_ln_route(args, C, layer); SEAM(base + 11); }
#endif

        if (RUNS(12) || RUNS(13)) { WSL(ws);
            LAS int* tab = (LAS int*)(C.lds + MISC_OFF + 64);
            __syncthreads();
            if (C.tid == 0) { int pre = 0; const unsigned* cnt = (const unsigned*)(ws + WS_CTL) + CW_CNT + layer * 16 * 64;
                for (int e = 0; e < 16; ++e) { const int n = (int)__hip_atomic_load(cnt + e * 64, __ATOMIC_RELAXED, __HIP_MEMORY_SCOPE_AGENT); tab[e] = pre; tab[17 + e] = n; pre += (n + 255) >> 8; }
                tab[16] = pre; }
            __syncthreads();
            #if SITE_ON(11)
        if (RUNS(12)) {
                pg8::MoeOrder S{tab, (const char*)(ws + WS_XS), (const char*)(ws + WS_MW1 + (size_t)layer * 16 * SZ_MW1), (size_t)8192 * 2048 * 2, SZ_MW1, (size_t)256 * 2048 * 2, (size_t)256 * 2048 * 2, C.G, (int)blockIdx.x};
                pg8::EpiMoe1 E{(bf16*)(ws + WS_ACT)};
                pg8::gemm_phase<pg8::EpiMoe1, pg8::MoeOrder, true, true>(C.lds, 2048, S, E);
                SEAM(base + 12);
            }
#endif

            #if SITE_ON(12)
        if (RUNS(13)) {
                pg8::MoeOrder S{tab, (const char*)(ws + WS_ACT), (const char*)(ws + WS_MW2 + (size_t)layer * 16 * SZ_MW2), (size_t)8192 * 1024 * 2, SZ_MW2, (size_t)256 * 1024 * 2, (size_t)256 * 1024 * 2, C.G, (int)blockIdx.x};
                pg8::EpiMoe2 E{(const int*)(ws + WS_DST), (const float*)(ws + WS_GATE), (bf16*)(ws + WS_YB)};
                pg8::gemm_phase<pg8::EpiMoe2, pg8::MoeOrder, true, true>(C.lds, 1024, S, E);
                SEAM(base + 13);
            }
#endif

        }
        #if SITE_ON(13)
        if (RUNS(14)) { phase_ln_ffn(args, C, layer); SEAM(base + 14); }
#endif

    }
#undef RUN
#undef RUNS
#undef SEAM
}

extern "C" void kernel_launch(void* const* d_in, const int* in_sizes, int n_in, void* d_out, int out_size, void* d_ws, size_t ws_size, hipStream_t stream) {
    static int grid = 0;
    if (grid == 0) {
        if (n_in != 34 || out_size != T * D || ws_size < WS_END) { fprintf(stderr, "kernel_launch: unexpected shapes (n_in %d, out %d, ws %zu < %zu)\n", n_in, out_size, ws_size, (size_t)WS_END); grid = -1; return; }
        int dev = 0, cus = 0, per_cu = 0;
        if (hipGetDevice(&dev) != hipSuccess || hipDeviceGetAttribute(&cus, hipDeviceAttributeMultiprocessorCount, dev) != hipSuccess) { grid = -1; return; }
        if (hipFuncSetAttribute((const void*)trunk_fwd, hipFuncAttributeMaxDynamicSharedMemorySize, LDS_BYTES) != hipSuccess) { fprintf(stderr, "kernel_launch: hipFuncSetAttribute failed\n"); grid = -1; return; }
        if (hipOccupancyMaxActiveBlocksPerMultiprocessor(&per_cu, (const void*)trunk_fwd, NTHR, LDS_BYTES) != hipSuccess || per_cu < 1) { fprintf(stderr, "kernel_launch: occupancy query says %d blocks per CU\n", per_cu); }
        (void)hipGetLastError();
        grid = cus;
    }
    if (grid < 0) return;
    (void)in_sizes;
    if (hipMemsetAsync((char*)d_ws + WS_CTL, 0, CTL_BYTES, stream) != hipSuccess) return;
    Args a{};
    for (int i = 0; i < 34; ++i) a.in[i] = d_in[i];
    a.out = (float*)d_out; a.ws = (unsigned char*)d_ws;
#if MK_ONE_LAUNCH
    a.ph_lo = 0; a.ph_hi = PH_END;
    hipLaunchKernelGGL(trunk_fwd, dim3(grid), dim3(NTHR), LDS_BYTES, stream, a);
#else
    for (int ph = 0; ph < PH_END; ++ph) {
        if (ph > 0 && !slot_active((ph - 1) / 16, (ph - 1) % 16)) continue;
        a.ph_lo = ph; a.ph_hi = ph + 1;
        hipLaunchKernelGGL(trunk_fwd, dim3(grid), dim3(NTHR), LDS_BYTES, stream, a);
    }
#endif
}
```

```cpp
#include <hip/hip_runtime.h>
#include <cstdio>
#include <cstdint>

#ifndef DUP_MASK
#define DUP_MASK 0
#endif
#define DUPN(b) (1 + ((DUP_MASK >> (b)) & 1))
#ifndef MK_ONE_LAUNCH
#define MK_ONE_LAUNCH 1
#endif

namespace pg8 {
#define PG8_LAS __attribute__((address_space(3)))
typedef unsigned short bf16_t;
typedef short bf16x8 __attribute__((ext_vector_type(8)));
typedef float f32x4 __attribute__((ext_vector_type(4)));
typedef float f32x2 __attribute__((ext_vector_type(2)));
typedef unsigned u32x4 __attribute__((ext_vector_type(4)));
typedef unsigned u32x2 __attribute__((ext_vector_type(2)));
constexpr int BM = 256, BK = 64, HALF = 128, HTB = HALF * BK * 2  , STAGE_BYTES = 8 * HTB, NXCD = 8, WGM = 8;

__host__ __device__ __forceinline__ int lds_byte(int r, int c) { const int st = (r >> 4) * 2 + (c >> 5), rr = r & 15, cc = c & 31, ob = rr * 64 + cc * 2; return st * 1024 + (ob ^ (((ob >> 9) & 1) << 5)); }
__host__ __device__ __forceinline__ void stage_rc(int b, int& R, int& C) { const int st = b / 1024, sb = b % 1024, swz = sb ^ (((sb >> 9) & 1) << 5); R = (st >> 1) * 16 + swz / 64; C = (st & 1) * 32 + (swz % 64) / 2; }
__host__ __device__ __forceinline__ int perm32(int rho) { const int n = rho >> 4, i = rho & 15; return 8 * (i >> 2) + 4 * n + (i & 3); }

struct Unit { const char* A; const char* B; int pm, pn, e, rows; };

struct StaticOrder {
    const char* A0; const char* B0; size_t tstep; int nM, nN, nwg, G, c;
    __device__ void init(const void* A, const void* Bt, int K, int nM_, int nN_, int G_, int c_) { A0 = (const char*)A; B0 = (const char*)Bt; tstep = (size_t)BM * K * 2; nM = nM_; nN = nN_; nwg = nM * nN; G = G_; c = c_; }
    __device__ bool next(int i, Unit& u) const {
        const long L = (long)i * G + c; if (L >= nwg) return false;
        int wgid = (int)L; { const int q = nwg / NXCD, r = nwg % NXCD, xcd = wgid % NXCD, off = wgid / NXCD; wgid = (xcd < r ? xcd * (q + 1) : r * (q + 1) + (xcd - r) * q) + off; }
        const int nig = WGM * nN, gid = wgid / nig, fm = gid * WGM, gsz = (nM - fm) < WGM ? (nM - fm) : WGM;
        u.pm = fm + ((wgid % nig) % gsz); u.pn = (wgid % nig) / gsz; u.e = 0; u.rows = BM;
        u.A = A0 + (size_t)u.pm * tstep; u.B = B0 + (size_t)u.pn * tstep; return true;
    }
    __device__ __forceinline__ void a_ready(const Unit&) const {}
    __device__ __forceinline__ void done(const Unit&) const {}
};
struct MoeOrder {
    const PG8_LAS int* tab; const char* A0; const char* B0; size_t a_es, b_es, a_ts, b_ts; int G, c;
    __device__ bool next(int i, Unit& u) const {
        const long uid = (long)i * G + c; const int total = __builtin_amdgcn_readfirstlane(tab[16]) * 8; if (uid >= total) return false;
        const int nt = (int)(uid & 7), v = (int)(uid >> 3); int e = 0;
#pragma unroll
        for (int k = 1; k < 16; ++k) e += (v >= tab[k]) ? 1 : 0;
        e = __builtin_amdgcn_readfirstlane(e);
        const int mt = __builtin_amdgcn_readfirstlane(v - tab[e]);
        const int rows = __builtin_amdgcn_readfirstlane(tab[17 + e]) - mt * BM;
        u.e = e; u.pm = mt; u.pn = nt; u.rows = rows < BM ? rows : BM;
        u.A = A0 + (size_t)e * a_es + (size_t)mt * a_ts; u.B = B0 + (size_t)e * b_es + (size_t)nt * b_ts; return true;
    }
    __device__ __forceinline__ void a_ready(const Unit&) const {}
    __device__ __forceinline__ void done(const Unit&) const {}
};

__device__ __forceinline__ unsigned cvt_pk_bf16(float lo, float hi) { unsigned r; asm volatile("v_cvt_pk_bf16_f32 %0, %1, %2" : "=v"(r) : "v"(lo), "v"(hi)); return r; }
__device__ __forceinline__ f32x2 gelu_pk(f32x2 v) {
    const f32x2 av = __builtin_elementwise_abs(v), d = av * 0.2316418882f + 1.0f;
    f32x2 t; t.x = __builtin_amdgcn_rcpf(d.x); t.y = __builtin_amdgcn_rcpf(d.y);
    f32x2 q = t * 0.5307027145f + (-0.7265760135f); q = q * t + 0.7107068705f; q = q * t + (-0.142248368f); q = q * t + 0.127414796f; q = q * t;
    const f32x2 s = (v * v) * (-0.72134752044f);
    f32x2 e; e.x = __builtin_amdgcn_exp2f(s.x); e.y = __builtin_amdgcn_exp2f(s.y);
    const f32x2 m = v * (q * e), r = v - m;
    f32x2 o; o.x = v.x < 0.f ? m.x : r.x; o.y = v.y < 0.f ? m.y : r.y; return o;
}
__device__ __forceinline__ float sigmoid_f(float x) { return __builtin_amdgcn_rcpf(1.0f + __expf(-x)); }
__device__ __forceinline__ float bf_lo(unsigned w) { return __uint_as_float(w << 16); }
__device__ __forceinline__ float bf_hi(unsigned w) { return __uint_as_float(w & 0xffff0000u); }

struct EpiWin {
    static constexpr bool PERM = true, AFTER_DRAIN = false;
    bf16_t* O; int ldc; int gelu_tiles; int rot_lo, rot_hi, rot_q_hi; const float* cs; const float* sn;
    __device__ __forceinline__ void operator()(const f32x4 (&acc)[2][2][4][2], const Unit& u, int wr, int wc, int fr, int fq) const {
        asm volatile("" : "+v"(fr), "+v"(fq));
        const int row0 = u.pm * BM + wr * 64 + fr, col0 = u.pn * BM + wc * 32 + 8 * fq;
        const bool g = u.pn < gelu_tiles, rot = (u.pn >= rot_lo) && (u.pn < rot_hi);
        const float qs = (u.pn < rot_q_hi) ? 0.0625f : 1.0f;
#pragma unroll
        for (int ai = 0; ai < 2; ++ai)
#pragma unroll
            for (int m = 0; m < 4; ++m) { const int row = row0 + ai * HALF + m * 16; bf16_t* rowp = O + (size_t)row * ldc + col0;
                f32x4 v[2][2];
#pragma unroll
                for (int bj = 0; bj < 2; ++bj) { v[bj][0] = acc[ai][bj][m][0]; v[bj][1] = acc[ai][bj][m][1]; }
                if (g) {
#pragma unroll
                    for (int bj = 0; bj < 2; ++bj)
#pragma unroll
                        for (int n = 0; n < 2; ++n) { f32x2 a = gelu_pk((f32x2){v[bj][n][0], v[bj][n][1]}), b = gelu_pk((f32x2){v[bj][n][2], v[bj][n][3]}); v[bj][n] = (f32x4){a.x, a.y, b.x, b.y}; }
                }
                if (rot) {
                    const int fi = wc * 32 + 8 * fq;
#pragma unroll
                    for (int n = 0; n < 2; ++n) { const f32x4 c4 = *(const f32x4*)(cs + (size_t)row * 128 + fi + 4 * n), s4 = *(const f32x4*)(sn + (size_t)row * 128 + fi + 4 * n);
                        const f32x4 x1 = v[0][n], x2 = v[1][n]; v[0][n] = (x1 * c4 - x2 * s4) * qs; v[1][n] = (x1 * s4 + x2 * c4) * qs; }
                }
#pragma unroll
                for (int bj = 0; bj < 2; ++bj) { u32x4 w; w.x = cvt_pk_bf16(v[bj][0][0], v[bj][0][1]); w.y = cvt_pk_bf16(v[bj][0][2], v[bj][0][3]); w.z = cvt_pk_bf16(v[bj][1][0], v[bj][1][1]); w.w = cvt_pk_bf16(v[bj][1][2], v[bj][1][3]);
                    *(u32x4*)(rowp + bj * HALF) = w; } }
    }
};
struct EpiWout {
    static constexpr bool PERM = true, AFTER_DRAIN = false;
    const bf16_t* xres; bf16_t* Z; float alpha;
    __device__ __forceinline__ void operator()(const f32x4 (&acc)[2][2][4][2], const Unit& u, int wr, int wc, int fr, int fq) const {
        asm volatile("" : "+v"(fr), "+v"(fq));
        const int row0 = u.pm * BM + wr * 64 + fr, col0 = u.pn * BM + wc * 32 + 8 * fq;
#pragma unroll
        for (int ai = 0; ai < 2; ++ai)
#pragma unroll
            for (int m = 0; m < 4; ++m) { const size_t off = (size_t)(row0 + ai * HALF + m * 16) * 2048 + col0;
#pragma unroll
                for (int bj = 0; bj < 2; ++bj) { const u32x4 xw = *(const u32x4*)(xres + off + bj * HALF); const f32x4 a0 = acc[ai][bj][m][0], a1 = acc[ai][bj][m][1];
                    u32x4 w; w.x = cvt_pk_bf16(bf_lo(xw.x) * alpha + a0[0], bf_hi(xw.x) * alpha + a0[1]); w.y = cvt_pk_bf16(bf_lo(xw.y) * alpha + a0[2], bf_hi(xw.y) * alpha + a0[3]);
                    w.z = cvt_pk_bf16(bf_lo(xw.z) * alpha + a1[0], bf_hi(xw.z) * alpha + a1[1]); w.w = cvt_pk_bf16(bf_lo(xw.w) * alpha + a1[2], bf_hi(xw.w) * alpha + a1[3]);
                    *(u32x4*)(Z + off + bj * HALF) = w; } }
    }
};
struct EpiGlu {
    static constexpr bool PERM = true, AFTER_DRAIN = false;
    const bf16_t* YS; const float* bias; bf16_t* YC;
    __device__ __forceinline__ void operator()(const f32x4 (&acc)[2][2][4][2], const Unit& u, int wr, int wc, int fr, int fq) const {
        asm volatile("" : "+v"(fr), "+v"(fq));
        const int row0 = u.pm * BM + wr * 64 + fr, col0 = u.pn * BM + wc * 32 + 8 * fq;
        f32x4 bv[2][2];
#pragma unroll
        for (int bj = 0; bj < 2; ++bj)
#pragma unroll
            for (int n = 0; n < 2; ++n) bv[bj][n] = *(const f32x4*)(bias + col0 + bj * HALF + 4 * n);
#pragma unroll
        for (int ai = 0; ai < 2; ++ai)
#pragma unroll
            for (int m = 0; m < 4; ++m) { const int row = row0 + ai * HALF + m * 16;
#pragma unroll
                for (int bj = 0; bj < 2; ++bj) { const u32x4 yw = *(const u32x4*)(YS + (size_t)row * 1024 + col0 + bj * HALF);
                    const f32x4 a0 = acc[ai][bj][m][0] + bv[bj][0], a1 = acc[ai][bj][m][1] + bv[bj][1];
                    u32x4 w;
                    w.x = cvt_pk_bf16(bf_lo(yw.x) * sigmoid_f(a0[0]), bf_hi(yw.x) * sigmoid_f(a0[1])); w.y = cvt_pk_bf16(bf_lo(yw.y) * sigmoid_f(a0[2]), bf_hi(yw.y) * sigmoid_f(a0[3]));
                    w.z = cvt_pk_bf16(bf_lo(yw.z) * sigmoid_f(a1[0]), bf_hi(yw.z) * sigmoid_f(a1[1])); w.w = cvt_pk_bf16(bf_lo(yw.w) * sigmoid_f(a1[2]), bf_hi(yw.w) * sigmoid_f(a1[3]));
                    *(u32x4*)(YC + (size_t)row * 2048 + col0 + bj * HALF) = w; } }
    }
};
struct EpiMoe1 {
    static constexpr bool PERM = true, AFTER_DRAIN = false;
    bf16_t* ACT;
    __device__ __forceinline__ void operator()(const f32x4 (&acc)[2][2][4][2], const Unit& u, int wr, int wc, int fr, int fq) const {
        asm volatile("" : "+v"(fr), "+v"(fq));
        const int col0 = u.pn * HALF + wc * 32 + 8 * fq;
        bf16_t* base = ACT + ((size_t)u.e * 8192 + (size_t)u.pm * BM) * 1024 + col0;
#pragma unroll
        for (int ai = 0; ai < 2; ++ai)
#pragma unroll
            for (int m = 0; m < 4; ++m) { const int r = ai * HALF + wr * 64 + m * 16 + fr;
                if (r < u.rows) { float o[8];
#pragma unroll
                    for (int n = 0; n < 2; ++n)
#pragma unroll
                        for (int j = 0; j < 4; ++j) { const float hg = acc[ai][0][m][n][j], hu = acc[ai][1][m][n][j]; o[4 * n + j] = hg * sigmoid_f(hg) * hu; }
                    u32x4 w; w.x = cvt_pk_bf16(o[0], o[1]); w.y = cvt_pk_bf16(o[2], o[3]); w.z = cvt_pk_bf16(o[4], o[5]); w.w = cvt_pk_bf16(o[6], o[7]);
                    *(u32x4*)(base + (size_t)r * 1024) = w; } }
    }
};
struct EpiMoe2 {
    static constexpr bool PERM = true, AFTER_DRAIN = false;
    const int* dst; const float* gate; bf16_t* YB;
    __device__ __forceinline__ void operator()(const f32x4 (&acc)[2][2][4][2], const Unit& u, int wr, int wc, int fr, int fq) const {
        asm volatile("" : "+v"(fr), "+v"(fq));
        const int col0 = u.pn * BM + wc * 32 + 8 * fq; const size_t rb = (size_t)u.e * 8192 + (size_t)u.pm * BM;
#pragma unroll
        for (int ai = 0; ai < 2; ++ai)
#pragma unroll
            for (int m = 0; m < 4; ++m) { const int r = ai * HALF + wr * 64 + m * 16 + fr;
                if (r < u.rows) { const int d = dst[rb + r]; const float gt = gate[rb + r]; bf16_t* rowp = YB + (size_t)d * 2048 + col0;
#pragma unroll
                    for (int bj = 0; bj < 2; ++bj) { const f32x4 v0 = acc[ai][bj][m][0] * gt, v1 = acc[ai][bj][m][1] * gt;
                        u32x4 w; w.x = cvt_pk_bf16(v0[0], v0[1]); w.y = cvt_pk_bf16(v0[2], v0[3]); w.z = cvt_pk_bf16(v1[0], v1[1]); w.w = cvt_pk_bf16(v1[2], v1[3]);
                        *(u32x4*)(rowp + bj * HALF) = w; } } }
    }
};

template <class Epi, class Sched, bool ALIGN_EPI = false, bool SP2 = false>
__device__ __forceinline__ void gemm_phase(PG8_LAS unsigned char* lds, const int Kdim, const Sched& S, const Epi& E) {
    int tid_ = threadIdx.x; asm volatile("" : "+v"(tid_));
    const int tid = tid_, wid = __builtin_amdgcn_readfirstlane(tid >> 6), lane = tid & 63, wr = wid >> 2, wc = wid & 3, fr = lane & 15, fq = lane >> 4;
    const int K = Kdim, nt = K / BK;
    unsigned voffA[2], voffB[2];
#pragma unroll
    for (int i = 0; i < 2; ++i) { int R, C; stage_rc(tid * 16 + i * 8192, R, C); const int Rb = Epi::PERM ? ((R & ~31) + perm32(R & 31)) : R;
        voffA[i] = (unsigned)(R * K + C) * 2u; voffB[i] = (unsigned)(Rb * K + C) * 2u; }
    const size_t kstep = (size_t)(BK * 2);
    const size_t hstep = (size_t)HALF * K * 2;
    const unsigned ldsw = (unsigned)wid * 1024u;
    const int aoff = lds_byte(wr * 64 + fr, fq * 8), boff = lds_byte(wc * 32 + fr, fq * 8);
#define PG8_SA(b, h) (((b) * 2 + (h)) * HTB)
#define PG8_SB(b, h) ((4 + (b) * 2 + (h)) * HTB)
#define PG8_STAGE(bufoff, gbase, voff) do { _Pragma("unroll") for (int _i = 0; _i < 2; ++_i) \
        __builtin_amdgcn_global_load_lds((const unsigned*)((const char*)(gbase) + (voff)[_i]), (PG8_LAS unsigned*)(lds + (bufoff) + ldsw + _i * 8192), 16, 0, 0); } while (0)
#define PG8_LDA(dst, b, h) do { _Pragma("unroll") for (int m = 0; m < 4; ++m) _Pragma("unroll") for (int k = 0; k < 2; ++k) dst[m][k] = *(const PG8_LAS bf16x8*)(lds + PG8_SA(b, h) + aoff + m * 2048 + k * 1024); } while (0)
#define PG8_LDB(dst, b, h) do { _Pragma("unroll") for (int n = 0; n < 2; ++n) _Pragma("unroll") for (int k = 0; k < 2; ++k) dst[n][k] = *(const PG8_LAS bf16x8*)(lds + PG8_SB(b, h) + boff + n * 2048 + k * 1024); } while (0)
#define PG8_MMA(ai, bj, At, Bt) do { __builtin_amdgcn_s_setprio(1); _Pragma("unroll") for (int m = 0; m < 4; ++m) _Pragma("unroll") for (int n = 0; n < 2; ++n) _Pragma("unroll") for (int k = 0; k < 2; ++k) \
        acc[ai][bj][m][n] = __builtin_amdgcn_mfma_f32_16x16x32_bf16(Bt[n][k], At[m][k], acc[ai][bj][m][n], 0, 0, 0); __builtin_amdgcn_s_setprio(0); } while (0)
#define PG8_WAIT_V(n) asm volatile("s_waitcnt vmcnt(" #n ")" ::: "memory")
#define PG8_WAIT_L(n) asm volatile("s_waitcnt lgkmcnt(" #n ")" ::: "memory")
#define PG8_BAR __builtin_amdgcn_s_barrier()
#define PG8_SCHED __builtin_amdgcn_sched_barrier(0)
    Unit cur, nxt; int ui = 0;
    if (!S.next(0, cur)) return;
    f32x4 acc[2][2][4][2];
#pragma unroll
    for (int a = 0; a < 2; ++a)
#pragma unroll
        for (int b = 0; b < 2; ++b)
#pragma unroll
            for (int m = 0; m < 4; ++m)
#pragma unroll
                for (int n = 0; n < 2; ++n) acc[a][b][m][n] = (f32x4){0.f, 0.f, 0.f, 0.f};
    bf16x8 At[4][2], B0[2][2], B1[2][2];
    const char* cA = cur.A; const char* cB = cur.B;
    S.a_ready(cur);
    if constexpr (SP2) {
        PG8_STAGE(PG8_SB(0, 0), cB, voffB); PG8_STAGE(PG8_SB(0, 1), cB + hstep, voffB); PG8_STAGE(PG8_SA(0, 0), cA, voffA); PG8_STAGE(PG8_SA(0, 1), cA + hstep, voffA);
        if (wr == 1) PG8_BAR;
        PG8_WAIT_V(2); PG8_BAR;
        PG8_STAGE(PG8_SB(1, 0), cB + kstep, voffB); PG8_STAGE(PG8_SA(1, 0), cA + kstep, voffA); PG8_STAGE(PG8_SB(1, 1), cB + hstep + kstep, voffB);
        PG8_WAIT_V(6); PG8_BAR;
    } else {
        PG8_STAGE(PG8_SB(0, 0), cB, voffB); PG8_STAGE(PG8_SA(0, 0), cA, voffA); PG8_STAGE(PG8_SB(0, 1), cB + hstep, voffB); PG8_STAGE(PG8_SA(0, 1), cA + hstep, voffA);
        if (wr == 1) PG8_BAR;
        PG8_WAIT_V(4); PG8_BAR;
        PG8_STAGE(PG8_SB(1, 0), cB + kstep, voffB); PG8_STAGE(PG8_SA(1, 0), cA + kstep, voffA); PG8_STAGE(PG8_SB(1, 1), cB + hstep + kstep, voffB);
        PG8_WAIT_V(6); PG8_BAR;
    }
    for (;;) {
        const bool has_next = S.next(ui + 1, nxt);
        const char* nA = has_next ? nxt.A : cA; const char* nB = has_next ? nxt.B : cB;
        for (int t = 0; t < nt; t += 2) {
            const bool last = (t == nt - 2);
            const char* a1 = cA + (size_t)(t + 1) * kstep;
            const char* a2 = last ? nA : cA + (size_t)(t + 2) * kstep; const char* b2 = last ? nB : cB + (size_t)(t + 2) * kstep;
            const char* a3 = a2 + kstep; const char* b3 = b2 + kstep;
            if (last && has_next) S.a_ready(nxt);
            if constexpr (SP2) {
            PG8_LDB(B0, 0, 0); PG8_LDB(B1, 0, 1); PG8_SCHED; PG8_LDA(At, 0, 0); PG8_STAGE(PG8_SA(1, 1), a1 + hstep, voffA);
            PG8_WAIT_V(8); PG8_WAIT_L(0); PG8_BAR; PG8_MMA(0, 0, At, B0); PG8_MMA(0, 1, At, B1); PG8_BAR; PG8_SCHED;
            PG8_LDA(At, 0, 1); PG8_STAGE(PG8_SB(0, 0), b2, voffB); PG8_STAGE(PG8_SB(0, 1), b2 + hstep, voffB); PG8_STAGE(PG8_SA(0, 0), a2, voffA);
            PG8_WAIT_V(8); PG8_WAIT_L(0); PG8_BAR; PG8_MMA(1, 0, At, B0); PG8_MMA(1, 1, At, B1); PG8_BAR; PG8_SCHED;
            PG8_LDB(B0, 1, 0); PG8_LDB(B1, 1, 1); PG8_SCHED; PG8_LDA(At, 1, 0); PG8_STAGE(PG8_SA(0, 1), a2 + hstep, voffA);
            PG8_WAIT_V(8); PG8_WAIT_L(0); PG8_BAR; PG8_MMA(0, 0, At, B0); PG8_MMA(0, 1, At, B1); PG8_BAR; PG8_SCHED;
            PG8_LDA(At, 1, 1); PG8_STAGE(PG8_SB(1, 0), b3, voffB); PG8_STAGE(PG8_SB(1, 1), b3 + hstep, voffB); PG8_STAGE(PG8_SA(1, 0), a3, voffA);
            PG8_WAIT_V(8); PG8_WAIT_L(0); PG8_BAR; PG8_MMA(1, 0, At, B0); PG8_MMA(1, 1, At, B1); PG8_BAR; PG8_SCHED;
            } else {
            PG8_LDB(B0, 0, 0); PG8_SCHED; PG8_LDA(At, 0, 0); PG8_STAGE(PG8_SA(1, 1), a1 + hstep, voffA);
            PG8_WAIT_L(8); PG8_BAR; PG8_WAIT_L(0); PG8_MMA(0, 0, At, B0); PG8_BAR; PG8_SCHED;
            PG8_LDB(B1, 0, 1); PG8_STAGE(PG8_SB(0, 0), b2, voffB);
            PG8_BAR; PG8_WAIT_L(0); PG8_MMA(0, 1, At, B1); PG8_BAR;
            PG8_LDA(At, 0, 1); PG8_STAGE(PG8_SA(0, 0), a2, voffA);
            PG8_BAR; PG8_WAIT_L(0); PG8_MMA(1, 0, At, B0); PG8_BAR; PG8_SCHED;
            PG8_STAGE(PG8_SB(0, 1), b2 + hstep, voffB);
            PG8_WAIT_V(6); PG8_BAR; PG8_MMA(1, 1, At, B1); PG8_BAR;
            PG8_LDB(B0, 1, 0); PG8_SCHED; PG8_LDA(At, 1, 0); PG8_STAGE(PG8_SA(0, 1), a2 + hstep, voffA);
            PG8_WAIT_L(8); PG8_BAR; PG8_WAIT_L(0); PG8_MMA(0, 0, At, B0); PG8_BAR; PG8_SCHED;
            PG8_LDB(B1, 1, 1); PG8_STAGE(PG8_SB(1, 0), b3, voffB);
            PG8_BAR; PG8_WAIT_L(0); PG8_MMA(0, 1, At, B1); PG8_BAR;
            PG8_LDA(At, 1, 1); PG8_STAGE(PG8_SA(1, 0), a3, voffA);
            PG8_BAR; PG8_WAIT_L(0); PG8_MMA(1, 0, At, B0); PG8_BAR; PG8_SCHED;
            PG8_STAGE(PG8_SB(1, 1), b3 + hstep, voffB);
            PG8_WAIT_V(6); PG8_BAR; PG8_MMA(1, 1, At, B1); PG8_BAR;
            }
        }
        if constexpr (ALIGN_EPI) { if (wr == 0) PG8_BAR; }
        if constexpr (!Epi::AFTER_DRAIN) { E(acc, cur, wr, wc, fr, fq); S.done(cur); }
        if (!has_next) break;
#pragma unroll
        for (int a = 0; a < 2; ++a)
#pragma unroll
            for (int b = 0; b < 2; ++b)
#pragma unroll
                for (int m = 0; m < 4; ++m)
#pragma unroll
                    for (int n = 0; n < 2; ++n) acc[a][b][m][n] = (f32x4){0.f, 0.f, 0.f, 0.f};
        cur = nxt; cA = nA; cB = nB; ++ui;
        if constexpr (ALIGN_EPI) { if (wr == 1) PG8_BAR; }
    }
    PG8_WAIT_V(0);
    if constexpr (!ALIGN_EPI) { if (wr == 0) PG8_BAR; }
    PG8_BAR;
    if constexpr (Epi::AFTER_DRAIN) { E.fused(acc, cur, wr, wc, fr, fq, lds, wid, lane); S.done(cur); }
#undef PG8_SA
#undef PG8_SB
#undef PG8_STAGE
#undef PG8_LDA
#undef PG8_LDB
#undef PG8_MMA
#undef PG8_WAIT_V
#undef PG8_WAIT_L
#undef PG8_BAR
#undef PG8_SCHED
}
}

constexpr int NWAVES = 8, NTHR = 512;
constexpr int T = 8192, D = 2048, SEQ = 2048;
constexpr int HE = 6144, HO = 5376, HO_SRC = 5136;
constexpr int DEPTH = 4;
constexpr float DN_ALPHA = 1.681792830507429f;
constexpr float LN_EPS = 1e-5f, RMS_EPS = 1e-6f;

#ifndef FAST_GATE
#define FAST_GATE 1
#endif
#ifndef FAST_RET
#define FAST_RET 1
#endif
#ifndef FAST_S5
#define FAST_S5 1
#endif
#ifndef FAST_DN
#define FAST_DN 1
#endif

constexpr size_t MiB = 1ull << 20;
constexpr size_t WS_CTL = 0, CTL_BYTES = MiB;
constexpr size_t SZ_WIE = 24 * MiB, SZ_WIO = 21 * MiB, SZ_WO = 8 * MiB, SZ_WGL = 2 * MiB, SZ_MW1 = 8 * MiB, SZ_MW2 = 4 * MiB;
constexpr size_t WS_WIE = WS_CTL + CTL_BYTES;
constexpr size_t WS_WIO = WS_WIE + 2 * SZ_WIE;
constexpr size_t WS_WOE = WS_WIO + 2 * SZ_WIO;
constexpr size_t WS_WOO = WS_WOE + 2 * SZ_WO;
constexpr size_t WS_WGL = WS_WOO + 2 * SZ_WO;
constexpr size_t WS_MW1 = WS_WGL + 2 * SZ_WGL;
constexpr size_t WS_MW2 = WS_MW1 + 64 * SZ_MW1;
constexpr size_t WS_COS = WS_MW2 + 64 * SZ_MW2;
constexpr size_t WS_SIN = WS_COS + 4 * MiB;
constexpr size_t WS_XF = WS_SIN + 4 * MiB;
constexpr size_t WS_Z = WS_XF + 64 * MiB;
constexpr size_t WS_XB = WS_Z + 64 * MiB;
constexpr size_t WS_H = WS_XB + 32 * MiB;
constexpr size_t WS_YC = WS_H + 96 * MiB;
constexpr size_t WS_XS = WS_YC + 32 * MiB;
constexpr size_t WS_ACT = WS_XS + 512 * MiB;
constexpr size_t WS_YB = WS_ACT + 256 * MiB;
constexpr size_t WS_DST = WS_YB + 64 * MiB;
constexpr size_t WS_GATE = WS_DST + MiB;
constexpr size_t WS_SCR = WS_GATE + MiB;
constexpr size_t SCR_BYTES = 640 * MiB;
constexpr size_t WS_END = WS_SCR + SCR_BYTES;
constexpr size_t SC_OI = 0;
constexpr size_t SC_OS = 32 * MiB;
constexpr size_t SC_VLN = 64 * MiB;
constexpr size_t SC_QR = 96 * MiB, SC_KR = 128 * MiB;
constexpr size_t SC_SC = 160 * MiB;
constexpr size_t SC_KV = 168 * MiB;
constexpr size_t SC_YS = 0;
constexpr size_t SC_X5 = 64 * MiB;
constexpr size_t SC_QN = 320 * MiB, SC_KN = 352 * MiB, SC_VN = 384 * MiB;
constexpr size_t SC_BETA = 416 * MiB, SC_G = 417 * MiB;
constexpr size_t SC_DO = 32 * MiB;
static_assert(SC_KV + 128 * MiB <= SCR_BYTES && SC_G + MiB <= SCR_BYTES, "scratch map");
constexpr int CW_BAR = 4096;
constexpr int CW_CNT = 16384;
static_assert((CW_CNT + 64 * 64) * 4 <= (int)CTL_BYTES, "ctl");

constexpr int RING_BYTES = 131072;
constexpr int MISC_OFF = 147456 - 256;
constexpr int LDS_BYTES = 147456;

#define LAS __attribute__((address_space(3)))
#define GAS __attribute__((address_space(1)))
typedef unsigned short bf16;
typedef float f32x4 __attribute__((ext_vector_type(4)));
typedef float f32x2 __attribute__((ext_vector_type(2)));
typedef unsigned v4u __attribute__((ext_vector_type(4)));
typedef unsigned v2u __attribute__((ext_vector_type(2)));
#define LDS_WAIT() asm volatile("s_waitcnt lgkmcnt(0)" ::: "memory")
#define VM_WAIT() asm volatile("s_waitcnt vmcnt(0)" ::: "memory")
__device__ __forceinline__ unsigned f2bf(float f) { unsigned u = __builtin_bit_cast(unsigned, f); return (u + 0x7fffu + ((u >> 16) & 1u)) >> 16; }
__device__ __forceinline__ unsigned pk2(float lo, float hi) { return f2bf(lo) | (f2bf(hi) << 16); }
__device__ __forceinline__ float bf2f(bf16 b) { return __uint_as_float(((unsigned)b) << 16); }
#define DPP_XOR1 0xB1
#define DPP_XOR2 0x4E
__device__ __forceinline__ float wave_sum(float v) {
    v += __builtin_bit_cast(float, __builtin_amdgcn_mov_dpp(__builtin_bit_cast(int, v), 0xB1, 0xF, 0xF, true));
    v += __builtin_bit_cast(float, __builtin_amdgcn_mov_dpp(__builtin_bit_cast(int, v), 0x4E, 0xF, 0xF, true));
    v += __builtin_bit_cast(float, __builtin_amdgcn_mov_dpp(__builtin_bit_cast(int, v), 0x141, 0xF, 0xF, true));
    v += __builtin_bit_cast(float, __builtin_amdgcn_mov_dpp(__builtin_bit_cast(int, v), 0x140, 0xF, 0xF, true));
    v += __builtin_bit_cast(float, __builtin_amdgcn_ds_swizzle(__builtin_bit_cast(int, v), 0x401F));
    return __builtin_bit_cast(float, __builtin_amdgcn_readlane(__builtin_bit_cast(int, v), 0)) + __builtin_bit_cast(float, __builtin_amdgcn_readlane(__builtin_bit_cast(int, v), 32));
}
__device__ __forceinline__ float quad_sum(float v) {
    v += __builtin_bit_cast(float, __builtin_amdgcn_mov_dpp(__builtin_bit_cast(int, v), 0xB1, 0xF, 0xF, true));
    v += __builtin_bit_cast(float, __builtin_amdgcn_mov_dpp(__builtin_bit_cast(int, v), 0x4E, 0xF, 0xF, true));
    return v;
}
__device__ __forceinline__ float silu_f(float x) { return x / (1.0f + __expf(-x)); }

#define XB_TMO      128
#define XB_XCNT(j)  (256  + 64 * (j))
#define XB_XSUB(j)  (1280 + 64 * (j))
#define XB_XGEN(j)  (2304 + 64 * (j))
#define XB_TOP      3328
#define XB_TOPGEN   3392
#define XCD_BAR_WORDS 3456
#define XB_SPIN_CAP (1u << 22)

__device__ __forceinline__ unsigned xb_ld(unsigned* p)              { return __hip_atomic_load(p, __ATOMIC_RELAXED, __HIP_MEMORY_SCOPE_AGENT); }
__device__ __forceinline__ unsigned xb_add(unsigned* p, unsigned v) { return __hip_atomic_fetch_add(p, v, __ATOMIC_RELAXED, __HIP_MEMORY_SCOPE_AGENT); }
__device__ __forceinline__ unsigned xb_xcc_id() { return (unsigned)__builtin_amdgcn_s_getreg((3 << 11) | 20) & 0xFu; }
#define XB_SPIN(cond, bar) do { unsigned _sp = 0; while (cond) { __builtin_amdgcn_s_sleep(1); \
    if ((++_sp & 255u) == 0u) { if (xb_ld(&(bar)[XB_TMO])) break; if (_sp > XB_SPIN_CAP) { atomicAdd(&(bar)[XB_TMO], 1u); break; } } } } while (0)

struct XcdBarrier { unsigned* bar; unsigned x; volatile LAS unsigned* st; };

__device__ __forceinline__ XcdBarrier xcd_barrier_post(unsigned* bar, volatile LAS unsigned* st) {
    XcdBarrier b; b.bar = bar; b.x = xb_xcc_id(); b.st = st;
    if (threadIdx.x == 0) (void)xb_add(&bar[XB_XCNT(b.x)], 1u);
    return b;
}
__device__ __forceinline__ void xcd_barrier_complete(unsigned* bar, unsigned x, unsigned& nloc, unsigned& nx) {
    const unsigned G = gridDim.x * gridDim.y * gridDim.z;
    unsigned sum, cnt, mine, sp = 0u;
    for (;;) {
        sum = 0u; cnt = 0u; mine = 0u;
#pragma unroll
        for (unsigned j = 0; j < 16; ++j) { const unsigned c = xb_ld(&bar[XB_XCNT(j)]); sum += c; cnt += (c > 0u) ? 1u : 0u; mine = (j == x) ? c : mine; }
        if (sum == G) break;
        __builtin_amdgcn_s_sleep(1);
        if ((++sp & 255u) == 0u) { if (xb_ld(&bar[XB_TMO])) break; if (sp > XB_SPIN_CAP) { atomicAdd(&bar[XB_TMO], 1u); break; } }
    }
    nloc = mine > 0u ? mine : 1u; nx = cnt > 0u ? cnt : 1u;
}
__device__ __forceinline__ void xcd_barrier(const XcdBarrier& b) {
    asm volatile("s_waitcnt vmcnt(0)" ::: "memory");
    __syncthreads();
    if (threadIdx.x == 0) {
        unsigned* bar = b.bar; unsigned bx = b.x;
        asm volatile("" : "+s"(bar), "+s"(bx));
        __builtin_amdgcn_s_waitcnt(0);
        unsigned nloc = b.st[0], nx = b.st[1];
        if (nloc == 0u) { xcd_barrier_complete(bar, bx, nloc, nx); b.st[0] = nloc; b.st[1] = nx; }
        const unsigned old = xb_add(&bar[XB_XSUB(bx)], 1u);
        const unsigned gen = old / nloc;
        if (old + 1u == (gen + 1u) * nloc) {
            __builtin_amdgcn_fence(__ATOMIC_RELEASE, "agent");
            asm volatile("s_waitcnt vmcnt(0)" ::: "memory");
            const unsigned og = xb_add(&bar[XB_TOP], 1u);
            const unsigned tg = og / nx;
            if (og + 1u == (tg + 1u) * nx) xb_add(&bar[XB_TOPGEN], 1u);
            else XB_SPIN(xb_ld(&bar[XB_TOPGEN]) == tg, bar);
            __builtin_amdgcn_fence(__ATOMIC_ACQUIRE, "agent");
            xb_add(&bar[XB_XGEN(bx)], 1u);
            asm volatile("s_waitcnt vmcnt(0)" ::: "memory");
        } else {
            XB_SPIN(xb_ld(&bar[XB_XGEN(bx)]) == gen, bar);
            __builtin_amdgcn_fence(__ATOMIC_ACQUIRE, "agent");
            asm volatile("s_waitcnt vmcnt(0)" ::: "memory");
        }
    }
    __syncthreads();
}

struct Args { const void* in[34]; float* out; unsigned char* ws; int ph_lo, ph_hi; };
typedef __attribute__((address_space(4))) const char karg_char;
__device__ __forceinline__ const void* argp(int i) {
    karg_char* kp = (karg_char*)__builtin_amdgcn_kernarg_segment_ptr();
    asm volatile("" : "+s"(kp));
    typedef const void* gptr_t; typedef __attribute__((address_space(4))) const gptr_t karg_ptr_t;
    return *(karg_ptr_t*)(kp + 8 * i);
}
#define INF(i) ((const float*)argp(i))

struct Ctx { LAS unsigned char* lds; unsigned char* ws; int tid, lane, wave, G, gw, NGW, bid; size_t gtid, gsz; };
__device__ __forceinline__ Ctx fresh(const Ctx& C0) { Ctx C = C0; unsigned long long z = 0ull; asm volatile("" : "+v"(C.tid), "+s"(z), "+s"(C.bid)); C.ws = C0.ws + z;
    C.lane = C.tid & 63; C.gw = C.bid * 8 + C.wave; C.gtid = (size_t)C.bid * 512 + C.tid; return C; }

struct ConvItem { const float* W; bf16* WT; int K, Nsrc, src_n0, dst_n0, k0; };
__device__ __forceinline__ void conv_decode(const Ctx& C, int layer, int it, ConvItem& J) {
    unsigned char* ws = C.ws; const int odd = layer & 1, li = layer >> 1; int nbk, map = 0; const int n_in = odd ? 2688 : 3072;
    if (it < n_in) { J.W = odd ? INF(18) + (size_t)li * 2048 * HO_SRC : INF(10) + (size_t)li * 2048 * 6144; J.WT = (bf16*)(odd ? ws + WS_WIO + li * SZ_WIO : ws + WS_WIE + li * SZ_WIE); J.K = 2048; J.Nsrc = odd ? HO_SRC : 6144; nbk = odd ? 84 : 96; }
    else { it -= n_in;
        if (it < 1024) { J.W = (odd ? INF(19) : INF(11)) + (size_t)li * 2048 * 2048; J.WT = (bf16*)(odd ? ws + WS_WOO + li * SZ_WO : ws + WS_WOE + li * SZ_WO); J.K = 2048; J.Nsrc = 2048; nbk = 32; }
        else { it -= 1024; bool done = false;
            if (odd) { if (it < 256) { J.W = INF(28) + (size_t)li * 1024 * 1024; J.WT = (bf16*)(ws + WS_WGL + li * SZ_WGL); J.K = 1024; J.Nsrc = 1024; nbk = 16; done = true; } else it -= 256; }
            if (!done) {
                if (it < 16384) { const int e = it >> 10; it &= 1023; J.W = INF(8) + (size_t)(layer * 16 + e) * 2048 * 2048; J.WT = (bf16*)(ws + WS_MW1 + (size_t)(layer * 16 + e) * SZ_MW1); J.K = 2048; J.Nsrc = 2048; nbk = 32; map = 1; }
                else { it -= 16384; const int e = it >> 9; it &= 511; J.W = INF(9) + (size_t)(layer * 16 + e) * 1024 * 2048; J.WT = (bf16*)(ws + WS_MW2 + (size_t)(layer * 16 + e) * SZ_MW2); J.K = 1024; J.Nsrc = 2048; nbk = 32; } } } }
    const int kb = it / nbk, nb = it - kb * nbk; J.k0 = 64 * kb; J.dst_n0 = 64 * nb; J.src_n0 = J.dst_n0;
    if (map == 1) { const int tile = J.dst_n0 >> 8, within = J.dst_n0 & 255; J.src_n0 = (within < 128) ? (128 * tile + within) : (1024 + 128 * tile + within - 128); }
}
__host__ __device__ constexpr int conv_items(int layer) { return (layer & 1) ? (2688 + 1024 + 256 + 16384 + 8192) : (3072 + 1024 + 16384 + 8192); }
__device__ __forceinline__ void conv_load(const ConvItem& J, int lane, f32x4 (&v)[16]) {
    const int g = lane >> 4, col = J.src_n0 + 4 * (lane & 15); const bool ok = col < J.Nsrc; const GAS float* p = (const GAS float*)J.W + (size_t)(J.k0 + 2 * g) * J.Nsrc + col;
#pragma unroll
    for (int i = 0; i < 8; ++i) { v[2 * i] = ok ? *(const GAS f32x4*)(p + (size_t)(8 * i) * J.Nsrc) : (f32x4){0.f, 0.f, 0.f, 0.f}; v[2 * i + 1] = ok ? *(const GAS f32x4*)(p + (size_t)(8 * i + 1) * J.Nsrc) : (f32x4){0.f, 0.f, 0.f, 0.f}; }
}
__device__ __forceinline__ void conv_store(const ConvItem& J, int lane, const f32x4 (&v)[16], LAS bf16* Tt) {
    const int g = lane >> 4, c4 = 4 * (lane & 15);
#pragma unroll
    for (int i = 0; i < 8; ++i)
#pragma unroll
        for (int q = 0; q < 4; ++q) *(LAS unsigned*)(Tt + (c4 + q) * 72 + 8 * i + 2 * g) = pk2(v[2 * i][q], v[2 * i + 1][q]);
    LDS_WAIT(); asm volatile("" ::: "memory");
    GAS bf16* dst = (GAS bf16*)J.WT + (size_t)(J.dst_n0 + (lane >> 3)) * J.K + J.k0 + 8 * (lane & 7);
#pragma unroll
    for (int j = 0; j < 8; ++j) *(GAS v4u*)(dst + (size_t)(8 * j) * J.K) = *(const LAS v4u*)(Tt + (8 * j + (lane >> 3)) * 72 + 8 * (lane & 7));
    LDS_WAIT(); asm volatile("" ::: "memory");
}
__device__ __forceinline__ void conv_layer(const Ctx& C, int layer, int rank, int nranks) {
    LAS bf16* Tt = (LAS bf16*)(C.lds + C.wave * 9216);
    const int total = conv_items(layer); ConvItem Ja, Jb; f32x4 a[16], b[16];
    int it = rank; if (it < total) { conv_decode(C, layer, it, Ja); conv_load(Ja, C.lane, a); }
    while (it < total) {
        const int n1 = it + nranks; if (n1 < total) { conv_decode(C, layer, n1, Jb); conv_load(Jb, C.lane, b); }
        conv_store(Ja, C.lane, a, Tt); it = n1; if (it >= total) break;
        const int n2 = it + nranks; if (n2 < total) { conv_decode(C, layer, n2, Ja); conv_load(Ja, C.lane, a); }
        conv_store(Jb, C.lane, b, Tt); it = n2;
    }
}
__device__ __forceinline__ void phase_prologue(const Args& args, const Ctx& C0) {
    const Ctx C = fresh(C0);
    unsigned char* ws = C.ws;
    for (int layer = 0; layer < DEPTH; ++layer) conv_layer(C, layer, C.gw, C.NGW);
    const int* pos = (const int*)argp(1); float* cs = (float*)(ws + WS_COS); float* sn = (float*)(ws + WS_SIN);
    for (size_t i = C.gtid; i < (size_t)T * 128; i += C.gsz) { const int tok = (int)(i >> 7), f = (int)(i & 127);
        const float inv = powf(10000.0f, -(float)f / 128.0f); const float ang = (float)pos[tok] * inv; cs[i] = cosf(ang); sn[i] = sinf(ang); }
    const float* x = INF(0); bf16* XB = (bf16*)(ws + WS_XB);
    for (size_t i = C.gtid; i < (size_t)T * D / 4; i += C.gsz) { const f32x4 v = *(const f32x4*)(x + 4 * i); v2u o; o.x = pk2(v.x, v.y); o.y = pk2(v.z, v.w); *(v2u*)(XB + 4 * i) = o; }
}

__device__ __forceinline__ void ln_row(f32x4 (&v)[8], const float* g, const float* b, int lane) {
    float s = 0.f;
#pragma unroll
    for (int j = 0; j < 8; ++j) s += (v[j].x + v[j].y) + (v[j].z + v[j].w);
    const float mean = wave_sum(s) * (1.f / 2048.f); float s2 = 0.f;
#pragma unroll
    for (int j = 0; j < 8; ++j) { v[j] = v[j] - mean; s2 += (v[j].x * v[j].x + v[j].y * v[j].y) + (v[j].z * v[j].z + v[j].w * v[j].w); }
    const float rstd = 1.0f / sqrtf(wave_sum(s2) * (1.f / 2048.f) + LN_EPS);
#pragma unroll
    for (int j = 0; j < 8; ++j) { const f32x4 gg = *(const f32x4*)(g + 4 * lane + 256 * j), bb = *(const f32x4*)(b + 4 * lane + 256 * j); v[j] = v[j] * rstd * gg + bb; }
}
__device__ __forceinline__ void phase_ln_route(const Args& args, const Ctx& C0, int layer) {
    const Ctx C = fresh(C0);
    unsigned char* ws = C.ws;
    const bf16* Z = (const bf16*)(ws + WS_Z); bf16* XS = (bf16*)(ws + WS_XS); int* TOKROW = (int*)(ws + WS_DST + 768 * 1024);
    int* DST = (int*)(ws + WS_DST); float* GATE = (float*)(ws + WS_GATE); unsigned* cnt = (unsigned*)(ws + WS_CTL) + CW_CNT + layer * 16 * 64;
    const float* g = INF(4) + layer * 2048; const float* b = INF(5) + layer * 2048; const float* wr = INF(2); const float* rb = INF(3);
    const int lane = C.lane;
    LAS float* wT = (LAS float*)C.lds;
    for (int p = C.tid; p < 2048 * 4; p += NTHR) { const int i = p >> 2, e4 = p & 3; const f32x4 w4 = *(const f32x4*)(wr + (size_t)i * 16 + 4 * e4);
        wT[(4 * e4 + 0) * 2048 + i] = w4.x; wT[(4 * e4 + 1) * 2048 + i] = w4.y; wT[(4 * e4 + 2) * 2048 + i] = w4.z; wT[(4 * e4 + 3) * 2048 + i] = w4.w; }
    __syncthreads();
    for (int row = C.gw; row < T; row += C.NGW) {
        f32x4 v[8];
#pragma unroll
        for (int j = 0; j < 8; ++j) { const v2u zw = *(const v2u*)(Z + (size_t)row * 2048 + 4 * lane + 256 * j); v[j] = (f32x4){pg8::bf_lo(zw.x), pg8::bf_hi(zw.x), pg8::bf_lo(zw.y), pg8::bf_hi(zw.y)}; }
        ln_row(v, g, b, lane);
        float lg[16];
#pragma unroll
        for (int e = 0; e < 16; ++e) lg[e] = 0.f;
#pragma unroll
        for (int j = 0; j < 8; ++j)
        {
#pragma unroll
            for (int e = 0; e < 16; ++e) { const f32x4 w4 = *(const LAS f32x4*)(wT + e * 2048 + 256 * j + 4 * lane); lg[e] += (v[j].x * w4.x + v[j].y * w4.y) + (v[j].z * w4.z + v[j].w * w4.w); }
            __builtin_amdgcn_sched_barrier(0); }
#pragma unroll
        for (int e = 0; e < 16; ++e) lg[e] = wave_sum(lg[e]);
        float mx = lg[0];
#pragma unroll
        for (int e = 1; e < 16; ++e) mx = fmaxf(mx, lg[e]);
        float pr[16], sum = 0.f;
#pragma unroll
        for (int e = 0; e < 16; ++e) { pr[e] = expf(lg[e] - mx); sum += pr[e]; }
        const float rs = 1.0f / sum;
        float sel[16];
#pragma unroll
        for (int e = 0; e < 16; ++e) { pr[e] *= rs; sel[e] = pr[e] + rb[e]; }
        int grp = 0; float best = -3.0e38f;
#pragma unroll
        for (int gi = 0; gi < 4; ++gi) { const float a0 = sel[4 * gi], a1 = sel[4 * gi + 1], a2 = sel[4 * gi + 2], a3 = sel[4 * gi + 3];
            const float tot = (a0 + a1) + (a2 + a3), mn1 = fminf(fminf(a0, a1), fminf(a2, a3));
            const float h01 = fmaxf(a0, a1), l01 = fminf(a0, a1), h23 = fmaxf(a2, a3), l23 = fminf(a2, a3);
            const float top1 = fmaxf(h01, h23), top2 = fmaxf(fminf(h01, h23), fmaxf(l01, l23));
            (void)tot; (void)mn1;
            const float sc = top1 + top2; if (sc > best) { best = sc; grp = gi; } }
        float s4[4], p4[4];
#pragma unroll
        for (int k = 0; k < 4; ++k) { s4[k] = 0.f; p4[k] = 0.f; }
#pragma unroll
        for (int gi = 0; gi < 4; ++gi)
#pragma unroll
            for (int k = 0; k < 4; ++k) { s4[k] = (gi == grp) ? sel[4 * gi + k] : s4[k]; p4[k] = (gi == grp) ? pr[4 * gi + k] : p4[k]; }
        int i1 = 0; float b1 = s4[0];
#pragma unroll
        for (int k = 1; k < 4; ++k) if (s4[k] > b1) { b1 = s4[k]; i1 = k; }
        int i2 = -1; float b2 = -3.0e38f;
#pragma unroll
        for (int k = 0; k < 4; ++k) if (k != i1 && s4[k] > b2) { b2 = s4[k]; i2 = k; }
        float g1 = 0.f, g2 = 0.f;
#pragma unroll
        for (int k = 0; k < 4; ++k) { g1 = (k == i1) ? p4[k] : g1; g2 = (k == i2) ? p4[k] : g2; }
        const float gs = 1.0f / (g1 + g2); g1 *= gs; g2 *= gs;
        const int e1 = grp * 4 + i1, e2 = grp * 4 + i2;
        unsigned p1 = 0, p2 = 0;
        if (lane == 0) { p1 = __hip_atomic_fetch_add(cnt + e1 * 64, 1u, __ATOMIC_RELAXED, __HIP_MEMORY_SCOPE_AGENT); p2 = __hip_atomic_fetch_add(cnt + e2 * 64, 1u, __ATOMIC_RELAXED, __HIP_MEMORY_SCOPE_AGENT); }
        p1 = __builtin_amdgcn_readfirstlane(p1); p2 = __builtin_amdgcn_readfirstlane(p2);
        const size_t r1 = (size_t)e1 * 8192 + p1, r2 = (size_t)e2 * 8192 + p2;
        if (lane == 0) { DST[r1] = row * 2; DST[r2] = row * 2 + 1; GATE[r1] = g1; GATE[r2] = g2; TOKROW[row] = (int)r1; }
#pragma unroll
        for (int j = 0; j < 8; ++j) { v2u o; o.x = pk2(v[j].x, v[j].y); o.y = pk2(v[j].z, v[j].w);
            *(v2u*)(XS + r1 * 2048 + 4 * lane + 256 * j) = o; *(v2u*)(XS + r2 * 2048 + 4 * lane + 256 * j) = o; }
    }
}
__device__ __forceinline__ void phase_ln_ffn(const Args& args, const Ctx& C0, int layer) {
    const Ctx C = fresh(C0);
    unsigned char* ws = C.ws;
    const bf16* XS = (const bf16*)(ws + WS_XS); const int* TOKROW = (const int*)(ws + WS_DST + 768 * 1024); const bf16* YB = (const bf16*)(ws + WS_YB); bf16* XB = (bf16*)(ws + WS_XB);
    const float* g = INF(6) + layer * 2048; const float* b = INF(7) + layer * 2048; const int lane = C.lane;
    for (int row = C.gw; row < T; row += C.NGW) {
        f32x4 v[8]; const bf16* xrow = XS + (size_t)TOKROW[row] * 2048;
#pragma unroll
        for (int j = 0; j < 8; ++j) { const size_t c = 4 * lane + 256 * j; const v2u xw = *(const v2u*)(xrow + c); const f32x4 xv = (f32x4){pg8::bf_lo(xw.x), pg8::bf_hi(xw.x), pg8::bf_lo(xw.y), pg8::bf_hi(xw.y)};
            const v2u y0 = *(const v2u*)(YB + (size_t)(2 * row) * 2048 + c), y1 = *(const v2u*)(YB + (size_t)(2 * row + 1) * 2048 + c);
            f32x4 m; m.x = pg8::bf_lo(y0.x) + pg8::bf_lo(y1.x); m.y = pg8::bf_hi(y0.x) + pg8::bf_hi(y1.x); m.z = pg8::bf_lo(y0.y) + pg8::bf_lo(y1.y); m.w = pg8::bf_hi(y0.y) + pg8::bf_hi(y1.y);
            v[j] = xv * DN_ALPHA + m; }
        ln_row(v, g, b, lane);
#pragma unroll
        for (int j = 0; j < 8; ++j) { const size_t c = 4 * lane + 256 * j;
            v2u o; o.x = pk2(v[j].x, v[j].y); o.y = pk2(v[j].z, v[j].w); *(v2u*)(XB + (size_t)row * 2048 + c) = o;
            if (layer == DEPTH - 1) *(f32x4*)(args.out + (size_t)row * 2048 + c) = v[j]; }
    }
}

__device__ __forceinline__ float ret_log_gamma(int h) { return log1pf(-exp2f(-5.0f - (float)h)); }
__device__ __forceinline__ void nv_even_prep(const Args& args, const Ctx& C0, int li, bool do_vln, bool do_qk) {
    const Ctx C = fresh(C0);
    unsigned char* ws = C.ws; const bf16* H = (const bf16*)(ws + WS_H);
    float* VLN = (float*)(ws + WS_SCR + SC_VLN); float* QR = (float*)(ws + WS_SCR + SC_QR); float* KR = (float*)(ws + WS_SCR + SC_KR);
    const float* lg = INF(12) + li * 1024; const float* lb = INF(13) + li * 1024; const float* cs = (const float*)(ws + WS_COS); const float* sn = (const float*)(ws + WS_SIN);
    if (do_vln) for (int it = C.gw; it < T * 4; it += C.NGW) { const int tok = it >> 2, g = it & 3; const int c0 = g * 256 + 4 * C.lane;
        const v2u w = *(const v2u*)(H + (size_t)tok * HE + 1024 + c0);
        f32x4 v; v.x = pg8::bf_lo(w.x); v.y = pg8::bf_hi(w.x); v.z = pg8::bf_lo(w.y); v.w = pg8::bf_hi(w.y);
        const float mean = wave_sum((v.x + v.y) + (v.z + v.w)) * (1.f / 256.f); v = v - mean;
        const float rstd = 1.0f / sqrtf(wave_sum((v.x * v.x + v.y * v.y) + (v.z * v.z + v.w * v.w)) * (1.f / 256.f) + LN_EPS);
        *(f32x4*)(VLN + (size_t)tok * 1024 + c0) = v * rstd * *(const f32x4*)(lg + c0) + *(const f32x4*)(lb + c0); }
    if (do_qk) for (size_t i = C.gtid; i < (size_t)T * 512; i += C.gsz) { const int tok = (int)(i >> 9), h = (int)((i >> 7) & 3), f = (int)(i & 127);
        const float c = cs[(size_t)tok * 128 + f], s = sn[(size_t)tok * 128 + f]; const bf16* base = H + (size_t)tok * HE;
        const float q1 = bf2f(base[2048 + h * 256 + f]), q2 = bf2f(base[2048 + h * 256 + 128 + f]), k1 = bf2f(base[3072 + h * 256 + f]), k2 = bf2f(base[3072 + h * 256 + 128 + f]);
        QR[(size_t)tok * 1024 + h * 256 + f] = (q1 * c - q2 * s) * 0.0625f; QR[(size_t)tok * 1024 + h * 256 + 128 + f] = (q1 * s + q2 * c) * 0.0625f;
        KR[(size_t)tok * 1024 + h * 256 + f] = k1 * c - k2 * s; KR[(size_t)tok * 1024 + h * 256 + 128 + f] = k1 * s + k2 * c; }
}
__device__ __forceinline__ void nv_even_a(const Args& args, const Ctx& C0, int li, bool do_gate, bool do_ret) {
    const Ctx C = fresh(C0);
    unsigned char* ws = C.ws; const bf16* H = (const bf16*)(ws + WS_H); bf16* YC = (bf16*)(ws + WS_YC);
    const float* VLN = (const float*)(ws + WS_SCR + SC_VLN); const float* QR = (const float*)(ws + WS_SCR + SC_QR); const float* KR = (const float*)(ws + WS_SCR + SC_KR);
    float* SC = (float*)(ws + WS_SCR + SC_SC); float* KV = (float*)(ws + WS_SCR + SC_KV);
    const float* Wsp = INF(14) + (size_t)li * 4 * 128 * 128; const float* Bsp = INF(15) + li * 4 * 128;
    if (do_gate) for (size_t i = C.gtid; i < (size_t)T * 1024; i += C.gsz) { const int tok = (int)(i >> 10), c = (int)(i & 1023), g = c >> 8, ii = tok & 127, blk = tok & ~127;
        const float* wrow = Wsp + ((size_t)g * 128 + ii) * 128; const int jend = (ii >= 64) ? 128 : 64; float s = 0.f;
        for (int j = 0; j < jend; ++j) s += wrow[j] * VLN[(size_t)(blk + j) * 1024 + c];
        s += Bsp[g * 128 + ii];
        YC[(size_t)tok * 2048 + c] = (bf16)f2bf(bf2f(H[(size_t)tok * HE + c]) * s); }
    if (do_ret) for (size_t i = C.gtid; i < (size_t)512 * 4096; i += C.gsz) { const int ch = (int)(i >> 12), ii = (int)((i >> 6) & 63), jj = (int)(i & 63), n = ch & 31, h = (ch >> 5) & 3, b = ch >> 7;
        const float* q = QR + (size_t)(b * 2048 + n * 64 + ii) * 1024 + h * 256; const float* k = KR + (size_t)(b * 2048 + n * 64 + jj) * 1024 + h * 256; float s = 0.f;
        for (int d = 0; d < 256; ++d) s += q[d] * k[d];
        const int dd = ii > jj ? ii - jj : jj - ii; SC[i] = s * expf(ret_log_gamma(h) * (float)dd); }
    if (do_ret) for (size_t i = C.gtid; i < (size_t)512 * 65536; i += C.gsz) { const int ch = (int)(i >> 16), d = (int)((i >> 8) & 255), e = (int)(i & 255), n = ch & 31, h = (ch >> 5) & 3, b = ch >> 7;
        const float lgm = ret_log_gamma(h); const size_t t0 = (size_t)b * 2048 + n * 64; float s = 0.f;
        for (int j = 0; j < 64; ++j) s += KR[(t0 + j) * 1024 + h * 256 + d] * expf(lgm * (float)(63 - j)) * bf2f(H[(t0 + j) * HE + 4096 + h * 256 + e]);
        KV[i] = s; }
}
__device__ __forceinline__ void nv_even_b(const Args& args, const Ctx& C0) {
    const Ctx C = fresh(C0);
    unsigned char* ws = C.ws; const bf16* H = (const bf16*)(ws + WS_H);
    const float* SC = (const float*)(ws + WS_SCR + SC_SC); float* KV = (float*)(ws + WS_SCR + SC_KV); float* OI = (float*)(ws + WS_SCR + SC_OI);
    for (size_t i = C.gtid; i < (size_t)T * 1024; i += C.gsz) { const int tok = (int)(i >> 10), c = (int)(i & 1023), h = c >> 8, b = tok >> 11, n = (tok >> 6) & 31, ii = tok & 63;
        const int ch = (b * 4 + h) * 32 + n; const float* srow = SC + ((size_t)ch * 64 + ii) * 64; const size_t t0 = (size_t)(tok & ~63); float s = 0.f;
        for (int j = 0; j < 64; ++j) s += srow[j] * bf2f(H[(t0 + j) * HE + 4096 + c]);
        OI[i] = s; }
    for (size_t i = C.gtid; i < (size_t)16 * 65536; i += C.gsz) { const int bh = (int)(i >> 16), de = (int)(i & 65535), h = bh & 3;
        const float cd = expf(ret_log_gamma(h) * 64.0f); float st = 0.f;
        for (int n = 0; n < 32; ++n) { float* p = KV + ((size_t)(bh * 32 + n) << 16) + de; const float t = *p; *p = st; st = st * cd + t; } }
}
__device__ __forceinline__ void nv_even_c(const Args& args, const Ctx& C0) {
    const Ctx C = fresh(C0);
    unsigned char* ws = C.ws; const float* QR = (const float*)(ws + WS_SCR + SC_QR); const float* KV = (const float*)(ws + WS_SCR + SC_KV); float* OS = (float*)(ws + WS_SCR + SC_OS);
    for (size_t i = C.gtid; i < (size_t)T * 1024; i += C.gsz) { const int tok = (int)(i >> 10), c = (int)(i & 1023), h = c >> 8, e = c & 255, b = tok >> 11, n = (tok >> 6) & 31, ii = tok & 63;
        const int ch = (b * 4 + h) * 32 + n; const float* q = QR + (size_t)tok * 1024 + h * 256; const float* st = KV + ((size_t)ch << 16) + e; float s = 0.f;
        for (int d = 0; d < 256; ++d) s += q[d] * st[(size_t)d * 256];
        OS[i] = s * expf(ret_log_gamma(h) * (float)(ii + 1)); }
}
__device__ __forceinline__ void phase_even_normgate(const Args& args, const Ctx& C0, int li) {
    const Ctx C = fresh(C0);
    unsigned char* ws = C.ws; const bf16* H = (const bf16*)(ws + WS_H); bf16* YC = (bf16*)(ws + WS_YC);
    const float* OI = (const float*)(ws + WS_SCR + SC_OI); const float* OS = (const float*)(ws + WS_SCR + SC_OS);
    const float* gg = INF(16) + li * 1024; const float* gb = INF(17) + li * 1024;
    for (int it = C.gw; it < T * 4; it += C.NGW) { const int tok = it >> 2, h = it & 3; const int c0 = h * 256 + 4 * C.lane;
        f32x4 v = *(const f32x4*)(OI + (size_t)tok * 1024 + c0) + *(const f32x4*)(OS + (size_t)tok * 1024 + c0);
        const float mean = wave_sum((v.x + v.y) + (v.z + v.w)) * (1.f / 256.f); v = v - mean;
        const float rstd = 1.0f / sqrtf(wave_sum((v.x * v.x + v.y * v.y) + (v.z * v.z + v.w * v.w)) * (1.f / 256.f) + LN_EPS);
        v = v * rstd * *(const f32x4*)(gg + c0) + *(const f32x4*)(gb + c0);
        const v2u gw = *(const v2u*)(H + (size_t)tok * HE + 5120 + c0);
        v2u o; o.x = pk2(silu_f(pg8::bf_lo(gw.x)) * v.x, silu_f(pg8::bf_hi(gw.x)) * v.y); o.y = pk2(silu_f(pg8::bf_lo(gw.y)) * v.z, silu_f(pg8::bf_hi(gw.y)) * v.w);
        *(v2u*)(YC + (size_t)tok * 2048 + 1024 + c0) = o; }
}


typedef short bf16x8 __attribute__((ext_vector_type(8)));
__device__ __forceinline__ bf16x8 lds_frag(const LAS bf16* base, int stride, int row0, int k0, int lane) { return *(const LAS bf16x8*)(base + (row0 + (lane & 15)) * stride + k0 + 8 * (lane >> 4)); }
#define MMA16(a, b, c) __builtin_amdgcn_mfma_f32_16x16x32_bf16((a), (b), (c), 0, 0, 0)
__device__ __forceinline__ v2u pack4(f32x4 v) { v2u o; o.x = pk2(v.x, v.y); o.y = pk2(v.z, v.w); return o; }
__device__ __forceinline__ void unpack8(const v4u w, float (&f)[8]) { f[0] = pg8::bf_lo(w.x); f[1] = pg8::bf_hi(w.x); f[2] = pg8::bf_lo(w.y); f[3] = pg8::bf_hi(w.y); f[4] = pg8::bf_lo(w.z); f[5] = pg8::bf_hi(w.z); f[6] = pg8::bf_lo(w.w); f[7] = pg8::bf_hi(w.w); }

__device__ __forceinline__ void fast_gate_unit(const Args& args, const Ctx& C, int li, int unit) {
    unsigned char* ws = C.ws; const bf16* H = (const bf16*)(ws + WS_H); bf16* YC = (bf16*)(ws + WS_YC);
    LAS bf16* Wm = (LAS bf16*)C.lds;
    LAS bf16* VT = Wm + 128 * 136;
    const int g = unit & 3; const size_t tok0 = (size_t)(unit >> 2) * 128; const int lane = C.lane, w = C.wave;
    const float* Wsp = INF(14) + ((size_t)li * 4 + g) * 128 * 128; const float* Bsp = INF(15) + (li * 4 + g) * 128;
    const float* lg = INF(12) + li * 1024 + g * 256; const float* lb = INF(13) + li * 1024 + g * 256;
    { const int i = C.tid >> 2, j0 = (C.tid & 3) * 32; const float* wrow = Wsp + (size_t)i * 128 + j0; const bool dead = (i < 64) && (j0 >= 64);
#pragma unroll
        for (int q = 0; q < 4; ++q) { f32x4 a = *(const f32x4*)(wrow + 8 * q), b = *(const f32x4*)(wrow + 8 * q + 4); if (dead) { a = (f32x4){0.f, 0.f, 0.f, 0.f}; b = a; }
            v4u o; o.x = pk2(a.x, a.y); o.y = pk2(a.z, a.w); o.z = pk2(b.x, b.y); o.w = pk2(b.z, b.w); *(LAS v4u*)(Wm + i * 136 + j0 + 8 * q) = o; } }
    const f32x4 g4 = *(const f32x4*)(lg + 4 * lane), b4 = *(const f32x4*)(lb + 4 * lane);
#pragma unroll 2
    for (int it = 0; it < 8; ++it) { const int j = 2 * (w + 8 * it); f32x4 nv[2];
#pragma unroll
        for (int r = 0; r < 2; ++r) { const v2u wv = *(const v2u*)(H + (tok0 + j + r) * HE + 1024 + g * 256 + 4 * lane);
            f32x4 v; v.x = pg8::bf_lo(wv.x); v.y = pg8::bf_hi(wv.x); v.z = pg8::bf_lo(wv.y); v.w = pg8::bf_hi(wv.y);
            const float mean = wave_sum((v.x + v.y) + (v.z + v.w)) * (1.f / 256.f); v = v - mean;
            const float rstd = 1.0f / sqrtf(wave_sum((v.x * v.x + v.y * v.y) + (v.z * v.z + v.w * v.w)) * (1.f / 256.f) + LN_EPS);
            nv[r] = v * rstd * g4 + b4; }
#pragma unroll
        for (int q = 0; q < 4; ++q) *(LAS unsigned*)(VT + (4 * lane + q) * 136 + j) = pk2(nv[0][q], nv[1][q]); }
    __syncthreads();
    bf16x8 a[4];
#pragma unroll
    for (int ks = 0; ks < 4; ++ks) a[ks] = lds_frag(Wm, 136, 16 * w, 32 * ks, lane);
    const int i = 16 * w + (lane & 15); const float bi = Bsp[i]; const size_t tok = tok0 + i;
#pragma unroll 4
    for (int nt = 0; nt < 16; ++nt) { f32x4 acc = (f32x4){0.f, 0.f, 0.f, 0.f};
#pragma unroll
        for (int ks = 0; ks < 4; ++ks) acc = MMA16(lds_frag(VT, 136, 16 * nt, 32 * ks, lane), a[ks], acc);
        const int c = g * 256 + 16 * nt + 4 * (lane >> 4); const v2u uw = *(const v2u*)(H + tok * HE + c);
        f32x4 o; o.x = pg8::bf_lo(uw.x) * (acc.x + bi); o.y = pg8::bf_hi(uw.x) * (acc.y + bi); o.z = pg8::bf_lo(uw.y) * (acc.z + bi); o.w = pg8::bf_hi(uw.y) * (acc.w + bi);
        *(v2u*)(YC + tok * 2048 + c) = pack4(o); }
    __syncthreads();
}
__device__ __forceinline__ void fast_ret_intra_unit(const Ctx& C, int unit) {
    unsigned char* ws = C.ws; const bf16* H = (const bf16*)(ws + WS_H); float* OI = (float*)(ws + WS_SCR + SC_OI);
    LAS bf16* Qs = (LAS bf16*)C.lds;
    LAS bf16* Ks = Qs + 64 * 264;
    LAS bf16* VT = Ks + 64 * 264;
    LAS bf16* Sb = VT + 256 * 72;
    const int n = unit & 31, h = (unit >> 5) & 3, b = unit >> 7; const size_t tok0 = (size_t)b * 2048 + n * 64; const int lane = C.lane, w = C.wave;
#pragma unroll
    for (int k = 0; k < 4; ++k) { const int p = C.tid + 512 * k, row = p >> 5, cs = p & 31; const bf16* src = H + (tok0 + row) * HE + h * 256 + cs * 8;
        *(LAS v4u*)(Qs + row * 264 + cs * 8) = *(const v4u*)(src + 2048); *(LAS v4u*)(Ks + row * 264 + cs * 8) = *(const v4u*)(src + 3072);
        const int vrow = p & 63, vcs = p >> 6;
        const v4u vv = *(const v4u*)(H + (tok0 + vrow) * HE + h * 256 + vcs * 8 + 4096); LAS bf16* d = VT + (vcs * 8) * 72 + vrow;
        d[0] = (bf16)(vv.x & 0xffff); d[72] = (bf16)(vv.x >> 16); d[144] = (bf16)(vv.y & 0xffff); d[216] = (bf16)(vv.y >> 16); d[288] = (bf16)(vv.z & 0xffff); d[360] = (bf16)(vv.z >> 16); d[432] = (bf16)(vv.w & 0xffff); d[504] = (bf16)(vv.w >> 16); }
    __syncthreads();
    const float lgm = ret_log_gamma(h);
    { const int mt = w & 3; bf16x8 a[8];
#pragma unroll
        for (int ks = 0; ks < 8; ++ks) a[ks] = lds_frag(Qs, 264, 16 * mt, 32 * ks, lane);
#pragma unroll
        for (int t2 = 0; t2 < 2; ++t2) { const int nt = (w >> 2) * 2 + t2; f32x4 acc = (f32x4){0.f, 0.f, 0.f, 0.f};
#pragma unroll
            for (int ks = 0; ks < 8; ++ks) acc = MMA16(lds_frag(Ks, 264, 16 * nt, 32 * ks, lane), a[ks], acc);
            const int i = 16 * mt + (lane & 15), j0 = 16 * nt + 4 * (lane >> 4);
#pragma unroll
            for (int r = 0; r < 4; ++r) { const int dd = i > j0 + r ? i - (j0 + r) : (j0 + r) - i; acc[r] *= expf(lgm * (float)dd); }
            *(LAS v2u*)(Sb + i * 72 + j0) = pack4(acc); } }
    __syncthreads();
    { const int mt = w & 3; bf16x8 a[2];
#pragma unroll
        for (int ks = 0; ks < 2; ++ks) a[ks] = lds_frag(Sb, 72, 16 * mt, 32 * ks, lane);
        const int i = 16 * mt + (lane & 15);
#pragma unroll 4
        for (int k = 0; k < 8; ++k) { const int nt = (w >> 2) + 2 * k; f32x4 acc = (f32x4){0.f, 0.f, 0.f, 0.f};
#pragma unroll
            for (int ks = 0; ks < 2; ++ks) acc = MMA16(lds_frag(VT, 72, 16 * nt, 32 * ks, lane), a[ks], acc);
            *(f32x4*)(OI + (tok0 + i) * 1024 + h * 256 + 16 * nt + 4 * (lane >> 4)) = acc; } }
    __syncthreads();
}
__device__ __forceinline__ void fast_ret_state_unit(const Ctx& C, int unit) {
    unsigned char* ws = C.ws; const bf16* H = (const bf16*)(ws + WS_H); float* OS = (float*)(ws + WS_SCR + SC_OS);
    LAS bf16* Qs = (LAS bf16*)C.lds;
    LAS bf16* KdT = Qs + 64 * 264;
    LAS bf16* VT = KdT + 256 * 72;
    LAS bf16* StT = VT + 32 * 72;
    const int es = unit & 7, h = (unit >> 3) & 3, b = unit >> 5; const int lane = C.lane, w = C.wave, tid = C.tid;
    const float lgm = ret_log_gamma(h), g64 = expf(lgm * 64.0f);
    for (int i = tid; i < 32 * 264 / 2; i += NTHR) ((LAS unsigned*)StT)[i] = 0u;
    f32x4 st[2][2];
#pragma unroll
    for (int a = 0; a < 2; ++a)
#pragma unroll
        for (int c = 0; c < 2; ++c) st[a][c] = (f32x4){0.f, 0.f, 0.f, 0.f};
    v4u rq[4], rk[4], rv;
    const bf16* hb = H + (size_t)b * 2048 * HE + h * 256;
#define RS_LOAD(nn) do { _Pragma("unroll") for (int k = 0; k < 4; ++k) { const int p = tid + 512 * k, row = p >> 5, cs = p & 31; rq[k] = *(const v4u*)(hb + (size_t)((nn) * 64 + row) * HE + cs * 8 + 2048); \
            rk[k] = *(const v4u*)(hb + (size_t)((nn) * 64 + (p & 63)) * HE + (p >> 6) * 8 + 3072); } \
        { const int row = tid & 63, sg = (tid >> 6) & 3; rv = *(const v4u*)(hb + (size_t)((nn) * 64 + row) * HE + 4096 + es * 32 + sg * 8); } } while (0)
    RS_LOAD(0);
    for (int n = 0; n < 32; ++n) {
#pragma unroll
        for (int k = 0; k < 4; ++k) { const int p = tid + 512 * k, row = p >> 5, cs = p & 31; *(LAS v4u*)(Qs + row * 264 + cs * 8) = rq[k];
            const int krow = p & 63, kcs = p >> 6;
            float f[8]; unpack8(rk[k], f); const float dk = expf(lgm * (float)(63 - krow)); LAS bf16* d = KdT + (kcs * 8) * 72 + krow;
#pragma unroll
            for (int q = 0; q < 8; ++q) d[q * 72] = (bf16)f2bf(f[q] * dk); }
        if (tid < 256) { const int row = tid & 63, sg = tid >> 6; LAS bf16* d = VT + (sg * 8) * 72 + row;
            d[0] = (bf16)(rv.x & 0xffff); d[72] = (bf16)(rv.x >> 16); d[144] = (bf16)(rv.y & 0xffff); d[216] = (bf16)(rv.y >> 16); d[288] = (bf16)(rv.z & 0xffff); d[360] = (bf16)(rv.z >> 16); d[432] = (bf16)(rv.w & 0xffff); d[504] = (bf16)(rv.w >> 16); }
        if (n + 1 < 32) RS_LOAD(n + 1);
        __syncthreads();
        { const int mt = w & 3, nt = w >> 2; f32x4 acc = (f32x4){0.f, 0.f, 0.f, 0.f};
#pragma unroll
            for (int ks = 0; ks < 8; ++ks) acc = MMA16(lds_frag(StT, 264, 16 * nt, 32 * ks, lane), lds_frag(Qs, 264, 16 * mt, 32 * ks, lane), acc);
            const int i = 16 * mt + (lane & 15); const float qd = expf(lgm * (float)(i + 1));
            *(f32x4*)(OS + ((size_t)b * 2048 + n * 64 + i) * 1024 + h * 256 + es * 32 + 16 * nt + 4 * (lane >> 4)) = acc * qd; }
#pragma unroll
        for (int a = 0; a < 2; ++a) { const int mt = 2 * w + a; const bf16x8 k0 = lds_frag(KdT, 72, 16 * mt, 0, lane), k1 = lds_frag(KdT, 72, 16 * mt, 32, lane);
#pragma unroll
            for (int c = 0; c < 2; ++c) { f32x4 nw = (f32x4){0.f, 0.f, 0.f, 0.f}; nw = MMA16(k0, lds_frag(VT, 72, 16 * c, 0, lane), nw); nw = MMA16(k1, lds_frag(VT, 72, 16 * c, 32, lane), nw);
                st[a][c] = st[a][c] * g64 + nw; } }
        __syncthreads();
#pragma unroll
        for (int a = 0; a < 2; ++a)
#pragma unroll
            for (int c = 0; c < 2; ++c) *(LAS v2u*)(StT + (16 * c + (lane & 15)) * 264 + 16 * (2 * w + a) + 4 * (lane >> 4)) = pack4(st[a][c]);
    }
#undef RS_LOAD
    __syncthreads();
}
__device__ __forceinline__ void fast_even_mix(const Args& args, const Ctx& C0, int li) {
    const Ctx C = fresh(C0);
#if FAST_RET
    if (C.bid < 128) fast_ret_state_unit(C, C.bid);
#endif
    const int nw = FAST_RET ? C.G - 128 : C.G, me = FAST_RET ? C.bid - 128 : C.bid;
    if (me >= 0) {
#if FAST_GATE
        for (int u = me; u < 256; u += nw) fast_gate_unit(args, C, li, u);
#endif
#if FAST_RET
        for (int u = me; u < 512; u += nw) fast_ret_intra_unit(C, u);
#endif
    }
}


__device__ __forceinline__ void fast_s5_unit(const Args& args, const Ctx& C, int li, int unit) {
    unsigned char* ws = C.ws; const bf16* H = (const bf16*)(ws + WS_H); bf16* YS = (bf16*)(ws + WS_SCR + SC_YS);
    const int b = unit >> 6, g = unit & 63; const int lane = C.lane, w = C.wave, tid = C.tid, q = lane >> 4, cc = lane & 15;
    LAS bf16* Ut = (LAS bf16*)C.lds;
    LAS bf16* BBs = Ut + 4096;
    LAS float* Ef = (LAS float*)(C.lds + 16384);
    LAS float* buL = (LAS float*)(C.lds + 20480 + w * 13312);
    LAS bf16* Xb = (LAS bf16*)(C.lds + 20480 + w * 13312 + 8448);
    const int gp = (li * 64 + g) * 64 + lane;
    const float dt = expf(INF(27)[li * 64 + g]), are = INF(20)[gp], aim = INF(21)[gp];
    const float mag = expf(are * dt), lbr = mag * cosf(aim * dt), lbi = mag * sinf(aim * dt), den = are * are + aim * aim;
    const float fre = ((lbr - 1.0f) * are + lbi * aim) / den, fim = (lbi * are - (lbr - 1.0f) * aim) / den;
    if (w == 0) { const float* pbre = INF(22) + (size_t)gp * 16; const float* pbim = INF(23) + (size_t)gp * 16; float br[16], bi[16];
#pragma unroll
        for (int c4 = 0; c4 < 4; ++c4) { const f32x4 r4 = *(const f32x4*)(pbre + 4 * c4), i4 = *(const f32x4*)(pbim + 4 * c4);
#pragma unroll
            for (int k = 0; k < 4; ++k) { br[4 * c4 + k] = fre * r4[k] - fim * i4[k]; bi[4 * c4 + k] = fre * i4[k] + fim * r4[k]; } }
#pragma unroll
        for (int c8 = 0; c8 < 2; ++c8) { v4u o; o.x = pk2(br[8 * c8], br[8 * c8 + 1]); o.y = pk2(br[8 * c8 + 2], br[8 * c8 + 3]); o.z = pk2(br[8 * c8 + 4], br[8 * c8 + 5]); o.w = pk2(br[8 * c8 + 6], br[8 * c8 + 7]);
            *(LAS v4u*)(BBs + (2 * lane) * 16 + 8 * c8) = o;
            o.x = pk2(bi[8 * c8], bi[8 * c8 + 1]); o.y = pk2(bi[8 * c8 + 2], bi[8 * c8 + 3]); o.z = pk2(bi[8 * c8 + 4], bi[8 * c8 + 5]); o.w = pk2(bi[8 * c8 + 6], bi[8 * c8 + 7]);
            *(LAS v4u*)(BBs + (2 * lane + 1) * 16 + 8 * c8) = o; } }
    float l16r = lbr, l16i = lbi;
#pragma unroll
    for (int k = 0; k < 4; ++k) { const float nr = l16r * l16r - l16i * l16i, ni = 2.0f * l16r * l16i; l16r = nr; l16i = ni; }
    bf16x8 cf[4];
    { const float* pcr = INF(24) + ((size_t)(li * 64 + g) * 16 + cc) * 64; const float* pci = INF(25) + ((size_t)(li * 64 + g) * 16 + cc) * 64;
#pragma unroll
        for (int ks = 0; ks < 4; ++ks) { const f32x4 r4 = *(const f32x4*)(pcr + 16 * ks + 4 * q), i4 = *(const f32x4*)(pci + 16 * ks + 4 * q);
            v4u o; o.x = pk2(r4.x, -i4.x); o.y = pk2(r4.y, -i4.y); o.z = pk2(r4.z, -i4.z); o.w = pk2(r4.w, -i4.w); cf[ks] = __builtin_bit_cast(bf16x8, o); } }
    const float dsk = INF(26)[(li * 64 + g) * 16 + cc];
    __syncthreads();
    bf16x8 bbf[8];
#pragma unroll
    for (int nt = 0; nt < 8; ++nt) { v4u o = (v4u){0u, 0u, 0u, 0u}; if (q < 2) o = *(const LAS v4u*)(BBs + (16 * nt + cc) * 16 + 8 * q); bbf[nt] = __builtin_bit_cast(bf16x8, o); }
    const size_t tokb = (size_t)b * 2048;
    const int lrow = tid >> 2, lpc = tid & 3;
    v2u ureg = *(const v2u*)(H + (tokb + lrow) * HO + g * 16 + 4 * lpc);
    float cr = 0.f, ci = 0.f;
    for (int tile = 0; tile < 16; ++tile) {
        *(LAS v2u*)(Ut + lrow * 16 + 4 * lpc) = ureg;
        if (tile + 1 < 16) ureg = *(const v2u*)(H + (tokb + (tile + 1) * 128 + lrow) * HO + g * 16 + 4 * lpc);
        __syncthreads();
        { v4u ao = (v4u){0u, 0u, 0u, 0u}; if (q < 2) ao = *(const LAS v4u*)(Ut + (16 * w + cc) * 16 + 8 * q); const bf16x8 af = __builtin_bit_cast(bf16x8, ao);
#pragma unroll
            for (int nt = 0; nt < 8; ++nt) { f32x4 acc = (f32x4){0.f, 0.f, 0.f, 0.f}; acc = MMA16(af, bbf[nt], acc);
#pragma unroll
                for (int r = 0; r < 4; ++r) buL[(4 * q + r) * 132 + 16 * nt + cc] = acc[r]; } }
        float ue[4];
#pragma unroll
        for (int r = 0; r < 4; ++r) ue[r] = bf2f(Ut[(16 * w + 4 * q + r) * 16 + cc]);
        LDS_WAIT();
        float xr = 0.f, xi = 0.f;
#pragma unroll
        for (int t = 0; t < 16; ++t) { const f32x2 bu = *(const LAS f32x2*)(buL + t * 132 + 2 * lane);
            const float nr = lbr * xr - lbi * xi + bu.x, ni = lbr * xi + lbi * xr + bu.y; xr = nr; xi = ni;
            *(LAS f32x2*)(buL + t * 132 + 2 * lane) = (f32x2){xr, xi}; }
        *(LAS f32x2*)(Ef + (w * 64 + lane) * 2) = (f32x2){xr, xi};
        __syncthreads();
        float sr = cr, si = ci, mr = 0.f, mi = 0.f;
#pragma unroll
        for (int v = 0; v < 8; ++v) { if (v == w) { mr = sr; mi = si; } const f32x2 e = *(const LAS f32x2*)(Ef + (v * 64 + lane) * 2);
            const float nr = l16r * sr - l16i * si + e.x, ni = l16r * si + l16i * sr + e.y; sr = nr; si = ni; }
        cr = sr; ci = si;
        float pr = lbr, pi = lbi;
#pragma unroll
        for (int t = 0; t < 16; ++t) { const f32x2 xl = *(const LAS f32x2*)(buL + t * 132 + 2 * lane);
            const float x0 = xl.x + pr * mr - pi * mi, x1 = xl.y + pr * mi + pi * mr;
            *(LAS unsigned*)(Xb + t * 136 + 2 * lane) = pk2(x0, x1);
            const float nr = pr * lbr - pi * lbi, ni = pr * lbi + pi * lbr; pr = nr; pi = ni; }
        LDS_WAIT();
        { f32x4 acc = (f32x4){0.f, 0.f, 0.f, 0.f};
#pragma unroll
            for (int ks = 0; ks < 4; ++ks) acc = MMA16(lds_frag(Xb, 136, 0, 32 * ks, lane), cf[ks], acc);
#pragma unroll
            for (int r = 0; r < 4; ++r) { const int t = 16 * w + 4 * q + r; const float s = acc[r] + dsk * ue[r];
                YS[(tokb + tile * 128 + t) * 1024 + g * 16 + cc] = (bf16)f2bf(0.5f * s * (1.0f + erff(s * 0.70710678118654752f))); } }
    }
    __syncthreads();
}


constexpr size_t SC_DUT = 64 * MiB;
constexpr size_t SC_DW = 80 * MiB;
constexpr size_t SC_DAT = 96 * MiB;
constexpr size_t SC_DQD = 104 * MiB;
constexpr size_t SC_DKT = 120 * MiB;
constexpr size_t SC_DGL = 136 * MiB;

__device__ __forceinline__ float oct_sum(float v) {
    v += __builtin_bit_cast(float, __builtin_amdgcn_mov_dpp(__builtin_bit_cast(int, v), 0xB1, 0xF, 0xF, true));
    v += __builtin_bit_cast(float, __builtin_amdgcn_mov_dpp(__builtin_bit_cast(int, v), 0x4E, 0xF, 0xF, true));
    v += __builtin_bit_cast(float, __builtin_amdgcn_mov_dpp(__builtin_bit_cast(int, v), 0x141, 0xF, 0xF, true));
    return v;
}
__device__ __forceinline__ f32x4 prod64(const LAS bf16* A, const LAS bf16* Bt, int mt, int nt, int lane, f32x4 acc) {
#pragma unroll
    for (int ks = 0; ks < 2; ++ks) acc = MMA16(lds_frag(Bt, 72, 16 * nt, 32 * ks, lane), lds_frag(A, 72, 16 * mt, 32 * ks, lane), acc);
    return acc;
}
__device__ __forceinline__ void put_both(f32x4 acc, LAS bf16* Dr, LAS bf16* Dt, int mt, int nt, int lane) {
    const int i = 16 * mt + (lane & 15), j0 = 16 * nt + 4 * (lane >> 4);
    *(LAS v2u*)(Dr + i * 72 + j0) = pack4(acc);
#pragma unroll
    for (int r = 0; r < 4; ++r) Dt[(j0 + r) * 72 + i] = (bf16)f2bf(acc[r]);
}
__device__ __forceinline__ void fast_dn_local_unit(const Args& args, const Ctx& C, int li, int unit) {
    unsigned char* ws = C.ws; const bf16* H = (const bf16*)(ws + WS_H);
    const int tid = C.tid, w = C.wave, lane = C.lane, q = lane >> 4, cc = lane & 15;
    const int n = unit & 31, h = (unit >> 5) & 7, b = unit >> 8;
    LAS bf16* QL = (LAS bf16*)C.lds;
    LAS bf16* Kn = QL + 64 * 136;
    LAS bf16* KB = Kn + 64 * 136;
    LAS bf16* VbT = KB + 64 * 136;
    LAS bf16* KeT = VbT + 128 * 72;
    LAS bf16* X0 = KeT + 128 * 72;
    LAS bf16* X1 = X0 + 64 * 72;
    LAS bf16* X2 = X1 + 64 * 72;
    LAS float* gs = (LAS float*)(X2 + 64 * 72);
    LAS float* eg = gs + 64;
    LAS bf16* B0 = QL; LAS bf16* B1 = B0 + 64 * 72; LAS bf16* B2 = B1 + 64 * 72; LAS bf16* B3 = B2 + 64 * 72; LAS bf16* B4 = B3 + 64 * 72;
    const size_t tok0 = (size_t)b * 2048 + n * 64;
    const float* cw = INF(30) + (size_t)li * 4 * 3072;
    const int r = tid >> 3, cs = tid & 7; const size_t tok = tok0 + r; const int tp = n * 64 + r;
    const float braw = bf2f(H[tok * HO + 5120 + h]), araw = bf2f(H[tok * HO + 5128 + h]);
    const float beta = 1.0f / (1.0f + expf(-braw)); const float zz = araw + INF(32)[li * 8 + h]; const float gval = -expf(INF(31)[li * 8 + h]) * ((zz > 20.f) ? zz : log1pf(expf(zz)));
    if (cs == 0) gs[r] = gval;
    v4u qpk[2], kpk[2];
#pragma unroll 1
    for (int s = 0; s < 3; ++s) { const int chb = s * 1024 + h * 128 + 16 * cs; float acc[16];
#pragma unroll
        for (int i = 0; i < 16; ++i) acc[i] = 0.f;
#pragma unroll
        for (int k = 0; k < 4; ++k) { if (tp - 3 + k >= 0) { const bf16* xr = H + (tok - 3 + k) * HO + 1024 + chb; const float* wk = cw + k * 3072 + chb;
#pragma unroll
                for (int p = 0; p < 2; ++p) { float f[8]; unpack8(*(const v4u*)(xr + 8 * p), f); const f32x4 w0 = *(const f32x4*)(wk + 8 * p), w1 = *(const f32x4*)(wk + 8 * p + 4);
                    acc[8 * p] += w0.x * f[0]; acc[8 * p + 1] += w0.y * f[1]; acc[8 * p + 2] += w0.z * f[2]; acc[8 * p + 3] += w0.w * f[3];
                    acc[8 * p + 4] += w1.x * f[4]; acc[8 * p + 5] += w1.y * f[5]; acc[8 * p + 6] += w1.z * f[6]; acc[8 * p + 7] += w1.w * f[7]; } } }
        float ss = 0.f;
#pragma unroll
        for (int i = 0; i < 16; ++i) { acc[i] = silu_f(acc[i]); ss += acc[i] * acc[i]; }
        if (s < 2) { ss = oct_sum(ss); float sc = 1.0f / sqrtf(ss + RMS_EPS); if (s == 0) sc *= 0.08838834764831845f;
            LAS bf16* dst = (s == 0) ? QL : Kn;
#pragma unroll
            for (int p = 0; p < 2; ++p) { v4u o; o.x = pk2(acc[8 * p] * sc, acc[8 * p + 1] * sc); o.y = pk2(acc[8 * p + 2] * sc, acc[8 * p + 3] * sc); o.z = pk2(acc[8 * p + 4] * sc, acc[8 * p + 5] * sc); o.w = pk2(acc[8 * p + 6] * sc, acc[8 * p + 7] * sc);
                *(LAS v4u*)(dst + r * 136 + 16 * cs + 8 * p) = o;
                if (s == 0) qpk[p] = o;
                else { const float sb = sc * beta; v4u o2; o2.x = pk2(acc[8 * p] * sb, acc[8 * p + 1] * sb); o2.y = pk2(acc[8 * p + 2] * sb, acc[8 * p + 3] * sb); o2.z = pk2(acc[8 * p + 4] * sb, acc[8 * p + 5] * sb); o2.w = pk2(acc[8 * p + 6] * sb, acc[8 * p + 7] * sb);
                    *(LAS v4u*)(KB + r * 136 + 16 * cs + 8 * p) = o2; kpk[p] = o2; } }
        } else {
#pragma unroll
            for (int i = 0; i < 16; ++i) VbT[(16 * cs + i) * 72 + r] = (bf16)f2bf(acc[i] * beta);
        } }
    __syncthreads();
    if (w == 0) { float v = gs[lane];
#pragma unroll
        for (int d = 1; d < 64; d <<= 1) { gs[lane] = v; LDS_WAIT(); const float o = gs[lane >= d ? lane - d : lane]; LDS_WAIT(); if (lane >= d) v += o; }
        gs[lane] = v; eg[lane] = expf(v); }
    __syncthreads();
    const float glast = gs[63];
    { const float e = eg[r]; bf16* DQD = (bf16*)(ws + WS_SCR + SC_DQD) + (size_t)unit * 8192;
#pragma unroll
        for (int p = 0; p < 2; ++p) { float f[8]; unpack8(kpk[p], f);
#pragma unroll
            for (int k = 0; k < 8; ++k) KeT[(16 * cs + 8 * p + k) * 72 + r] = (bf16)f2bf(f[k] * e);
            unpack8(qpk[p], f); v4u o; o.x = pk2(f[0] * e, f[1] * e); o.y = pk2(f[2] * e, f[3] * e); o.z = pk2(f[4] * e, f[5] * e); o.w = pk2(f[6] * e, f[7] * e); *(v4u*)(DQD + r * 128 + 16 * cs + 8 * p) = o; } }
    { const int d = tid >> 2, jq = tid & 3; bf16* DKT = (bf16*)(ws + WS_SCR + SC_DKT) + (size_t)unit * 8192;
#pragma unroll
        for (int p = 0; p < 2; ++p) { float f[8];
#pragma unroll
            for (int k = 0; k < 8; ++k) { const int j = 16 * jq + 8 * p + k; f[k] = bf2f(Kn[j * 136 + d]) * expf(glast - gs[j]); }
            v4u o; o.x = pk2(f[0], f[1]); o.y = pk2(f[2], f[3]); o.z = pk2(f[4], f[5]); o.w = pk2(f[6], f[7]); *(v4u*)(DKT + d * 64 + 16 * jq + 8 * p) = o; } }
    if (tid == 0) ((float*)(ws + WS_SCR + SC_DGL))[unit] = expf(glast);
    const int mt = w & 3, nt0 = (w >> 2) * 2;
    f32x4 Tacc[2];
    { bf16x8 ak[4], aq[4]; bf16* DAT = (bf16*)(ws + WS_SCR + SC_DAT) + (size_t)unit * 4096;
#pragma unroll
        for (int ks = 0; ks < 4; ++ks) { ak[ks] = lds_frag(KB, 136, 16 * mt, 32 * ks, lane); aq[ks] = lds_frag(QL, 136, 16 * mt, 32 * ks, lane); }
        const int i = 16 * mt + cc; const float gci = gs[i];
#pragma unroll
        for (int t2 = 0; t2 < 2; ++t2) { const int nt = nt0 + t2; f32x4 la = (f32x4){0.f, 0.f, 0.f, 0.f}, aa = la;
            if (nt <= mt) {
#pragma unroll
                for (int ks = 0; ks < 4; ++ks) { const bf16x8 bk = lds_frag(Kn, 136, 16 * nt, 32 * ks, lane); la = MMA16(bk, ak[ks], la); aa = MMA16(bk, aq[ks], aa); }
                const f32x4 gcj = *(const LAS f32x4*)(gs + 16 * nt + 4 * q);
#pragma unroll
                for (int rr = 0; rr < 4; ++rr) { const int j = 16 * nt + 4 * q + rr; const float dec = expf(gci - gcj[rr]); la[rr] = (i > j) ? la[rr] * dec : 0.f; aa[rr] = (i >= j) ? aa[rr] * dec : 0.f; } }
            *(v2u*)(DAT + i * 64 + 16 * nt + 4 * q) = pack4(aa);
            put_both(la, X0, X1, mt, nt, lane);
            f32x4 t0;
#pragma unroll
            for (int rr = 0; rr < 4; ++rr) t0[rr] = ((i == 16 * nt + 4 * q + rr) ? 1.0f : 0.0f) - la[rr];
            Tacc[t2] = t0; *(LAS v2u*)(X2 + i * 72 + 16 * nt + 4 * q) = pack4(t0); } }
    __syncthreads();
#pragma unroll
    for (int t2 = 0; t2 < 2; ++t2) put_both(prod64(X0, X1, mt, nt0 + t2, lane, (f32x4){0.f, 0.f, 0.f, 0.f}), B0, B1, mt, nt0 + t2, lane);
    __syncthreads();
#define DN_STEP(Tin, Sr, St, Tout, Sr2, St2, LAST) do { _Pragma("unroll") for (int t2 = 0; t2 < 2; ++t2) { Tacc[t2] = prod64(Tin, St, mt, nt0 + t2, lane, Tacc[t2]); \
            *(LAS v2u*)(Tout + (16 * mt + cc) * 72 + 16 * (nt0 + t2) + 4 * q) = pack4(Tacc[t2]); \
            if (!(LAST)) put_both(prod64(Sr, St, mt, nt0 + t2, lane, (f32x4){0.f, 0.f, 0.f, 0.f}), Sr2, St2, mt, nt0 + t2, lane); } __syncthreads(); } while (0)
    DN_STEP(X2, B0, B1, B2, B3, B4, false);
    DN_STEP(B2, B3, B4, X2, B0, B1, false);
    DN_STEP(X2, B0, B1, B2, B3, B4, false);
    DN_STEP(B2, B3, B4, X2, B0, B1, false);
    DN_STEP(X2, B0, B1, B2, B3, B4, true);
#undef DN_STEP
    { bf16* DUT = (bf16*)(ws + WS_SCR + SC_DUT) + (size_t)unit * 8192; bf16* DW = (bf16*)(ws + WS_SCR + SC_DW) + (size_t)unit * 8192;
        const bf16x8 a0 = lds_frag(B2, 72, 16 * mt, 0, lane), a1 = lds_frag(B2, 72, 16 * mt, 32, lane);
#pragma unroll
        for (int k = 0; k < 4; ++k) { const int nt = (w >> 2) + 2 * k;
            f32x4 ua = (f32x4){0.f, 0.f, 0.f, 0.f}, wa = ua;
            ua = MMA16(a0, lds_frag(VbT, 72, 16 * nt, 0, lane), ua); ua = MMA16(a1, lds_frag(VbT, 72, 16 * nt, 32, lane), ua);
            wa = MMA16(lds_frag(KeT, 72, 16 * nt, 0, lane), a0, wa); wa = MMA16(lds_frag(KeT, 72, 16 * nt, 32, lane), a1, wa);
            *(v2u*)(DUT + (16 * nt + cc) * 64 + 16 * mt + 4 * q) = pack4(ua);
            *(v2u*)(DW + (16 * mt + cc) * 128 + 16 * nt + 4 * q) = pack4(wa); } }
    __syncthreads();
}
__device__ __forceinline__ void fast_dn_state_unit(const Ctx& C, int unit) {
    unsigned char* ws = C.ws; float* DOo = (float*)(ws + WS_SCR + SC_DO);
    const int es = unit & 3, h = (unit >> 2) & 7, b = unit >> 5; const int lane = C.lane, w = C.wave, tid = C.tid, q = lane >> 4, cc = lane & 15;
    LAS bf16* Ws = (LAS bf16*)C.lds;
    LAS bf16* Qs = Ws + 64 * 136;
    LAS bf16* Ks = Qs + 64 * 136;
    LAS bf16* As = Ks + 128 * 72;
    LAS bf16* StT = As + 64 * 72;
    LAS bf16* VnT = StT + 32 * 136;
    const int u0 = (b * 8 + h) * 32;
    const bf16* DUT = (const bf16*)(ws + WS_SCR + SC_DUT); const bf16* DW = (const bf16*)(ws + WS_SCR + SC_DW); const bf16* DAT = (const bf16*)(ws + WS_SCR + SC_DAT);
    const bf16* DQD = (const bf16*)(ws + WS_SCR + SC_DQD); const bf16* DKT = (const bf16*)(ws + WS_SCR + SC_DKT); const float* DGL = (const float*)(ws + WS_SCR + SC_DGL);
    for (int i = tid; i < 32 * 136 / 2; i += NTHR) ((LAS unsigned*)StT)[i] = 0u;
    f32x4 st[2]; st[0] = (f32x4){0.f, 0.f, 0.f, 0.f}; st[1] = st[0];
    const int mt = w & 3, nt = w >> 2;
    v4u rw[2], rqd[2], rk[2], ra; v2u ru; float gl;
#define DS_LOAD(nn) do { const size_t un = (size_t)(u0 + (nn)); _Pragma("unroll") for (int k = 0; k < 2; ++k) { const int p = tid + 512 * k; rw[k] = *(const v4u*)(DW + un * 8192 + 8 * p); rqd[k] = *(const v4u*)(DQD + un * 8192 + 8 * p); rk[k] = *(const v4u*)(DKT + un * 8192 + 8 * p); } \
        ra = *(const v4u*)(DAT + un * 4096 + 8 * tid); ru = *(const v2u*)(DUT + un * 8192 + (size_t)(es * 32 + 16 * nt + cc) * 64 + 16 * mt + 4 * q); gl = DGL[un]; } while (0)
    DS_LOAD(0);
    for (int n = 0; n < 32; ++n) {
#pragma unroll
        for (int k = 0; k < 2; ++k) { const int p = tid + 512 * k; *(LAS v4u*)(Ws + (p >> 4) * 136 + (p & 15) * 8) = rw[k]; *(LAS v4u*)(Qs + (p >> 4) * 136 + (p & 15) * 8) = rqd[k]; *(LAS v4u*)(Ks + (p >> 3) * 72 + (p & 7) * 8) = rk[k]; }
        *(LAS v4u*)(As + (tid >> 3) * 72 + (tid & 7) * 8) = ra;
        const v2u uu = ru; const float gcur = gl;
        if (n + 1 < 32) DS_LOAD(n + 1);
        __syncthreads();
        f32x4 pa = (f32x4){0.f, 0.f, 0.f, 0.f}, oa = pa;
#pragma unroll
        for (int ks = 0; ks < 4; ++ks) { const bf16x8 sf = lds_frag(StT, 136, 16 * nt, 32 * ks, lane); pa = MMA16(lds_frag(Ws, 136, 16 * mt, 32 * ks, lane), sf, pa); oa = MMA16(lds_frag(Qs, 136, 16 * mt, 32 * ks, lane), sf, oa); }
        { f32x4 vn; vn.x = pg8::bf_lo(uu.x) - pa.x; vn.y = pg8::bf_hi(uu.x) - pa.y; vn.z = pg8::bf_lo(uu.y) - pa.z; vn.w = pg8::bf_hi(uu.y) - pa.w;
            *(LAS v2u*)(VnT + (16 * nt + cc) * 72 + 16 * mt + 4 * q) = pack4(vn); }
        __syncthreads();
#pragma unroll
        for (int ks = 0; ks < 2; ++ks) oa = MMA16(lds_frag(As, 72, 16 * mt, 32 * ks, lane), lds_frag(VnT, 72, 16 * nt, 32 * ks, lane), oa);
        { float* op = DOo + ((size_t)b * 2048 + n * 64 + 16 * mt + 4 * q) * 1024 + h * 128 + es * 32 + 16 * nt + cc;
#pragma unroll
            for (int rr = 0; rr < 4; ++rr) op[(size_t)rr * 1024] = oa[rr]; }
#pragma unroll
        for (int c = 0; c < 2; ++c) { f32x4 nw = (f32x4){0.f, 0.f, 0.f, 0.f};
#pragma unroll
            for (int ks = 0; ks < 2; ++ks) nw = MMA16(lds_frag(Ks, 72, 16 * w, 32 * ks, lane), lds_frag(VnT, 72, 16 * c, 32 * ks, lane), nw);
            st[c] = st[c] * gcur + nw; }
        __syncthreads();
#pragma unroll
        for (int c = 0; c < 2; ++c) *(LAS v2u*)(StT + (16 * c + cc) * 136 + 16 * w + 4 * q) = pack4(st[c]);
    }
#undef DS_LOAD
    __syncthreads();
}
__device__ __forceinline__ void fast_odd_mix_a(const Args& args, const Ctx& C0, int li) {
    const Ctx C = fresh(C0);
    for (int u = C.bid; u < 1024; u += C.G) fast_dn_local_unit(args, C, li, u);
}

__device__ __forceinline__ void fast_odd_mix_b(const Args& args, const Ctx& C0, int li) {
    const Ctx C = fresh(C0);
    const int first = FAST_DN ? 128 : 32, nw = C.G - first, me = C.bid - first;
#if FAST_DN
    if (C.bid < 128) fast_dn_state_unit(C, C.bid);
#endif
#if FAST_S5
    if (me >= 0) for (int u = me; u < 256; u += nw) fast_s5_unit(args, C, li, u);
#endif
}

__device__ __forceinline__ void nv_odd_a(const Args& args, const Ctx& C0, int li, bool do_s5, bool do_dn) {
    const Ctx C = fresh(C0);
    unsigned char* ws = C.ws; const bf16* H = (const bf16*)(ws + WS_H); f32x2* X5 = (f32x2*)(ws + WS_SCR + SC_X5);
    const int lane = C.lane;
    if (do_s5) for (int it = C.gw; it < 256; it += C.NGW) { const int b = it >> 6, g = it & 63; const int gp = (li * 64 + g) * 64 + lane;
        const float dt = expf(INF(27)[li * 64 + g]), are = INF(20)[gp], aim = INF(21)[gp]; const float* pbre = INF(22); const float* pbim = INF(23);
        const float mag = expf(are * dt), lbr = mag * cosf(aim * dt), lbi = mag * sinf(aim * dt), den = are * are + aim * aim;
        const float fre = ((lbr - 1.0f) * are + lbi * aim) / den, fim = (lbi * are - (lbr - 1.0f) * aim) / den;
        float bbr[16], bbi[16];
#pragma unroll
        for (int c = 0; c < 16; ++c) { const float br = pbre[(size_t)gp * 16 + c], bi = pbim[(size_t)gp * 16 + c]; bbr[c] = fre * br - fim * bi; bbi[c] = fre * bi + fim * br; }
        float xr = 0.f, xi = 0.f;
        for (int t = 0; t < SEQ; ++t) { const size_t tok = (size_t)b * 2048 + t; const v4u u0 = *(const v4u*)(H + tok * HO + g * 16), u1 = *(const v4u*)(H + tok * HO + g * 16 + 8);
            float u[16]; u[0] = pg8::bf_lo(u0.x); u[1] = pg8::bf_hi(u0.x); u[2] = pg8::bf_lo(u0.y); u[3] = pg8::bf_hi(u0.y); u[4] = pg8::bf_lo(u0.z); u[5] = pg8::bf_hi(u0.z); u[6] = pg8::bf_lo(u0.w); u[7] = pg8::bf_hi(u0.w);
            u[8] = pg8::bf_lo(u1.x); u[9] = pg8::bf_hi(u1.x); u[10] = pg8::bf_lo(u1.y); u[11] = pg8::bf_hi(u1.y); u[12] = pg8::bf_lo(u1.z); u[13] = pg8::bf_hi(u1.z); u[14] = pg8::bf_lo(u1.w); u[15] = pg8::bf_hi(u1.w);
            float br = 0.f, bi = 0.f;
#pragma unroll
            for (int c = 0; c < 16; ++c) { br += bbr[c] * u[c]; bi += bbi[c] * u[c]; }
            const float nr = lbr * xr - lbi * xi + br, ni = lbr * xi + lbi * xr + bi; xr = nr; xi = ni;
            X5[(tok * 64 + g) * 64 + lane] = (f32x2){xr, xi}; } }
    float* QN = (float*)(ws + WS_SCR + SC_QN); float* KN = (float*)(ws + WS_SCR + SC_KN); float* VN = (float*)(ws + WS_SCR + SC_VN);
    float* BETA = (float*)(ws + WS_SCR + SC_BETA); float* GG = (float*)(ws + WS_SCR + SC_G);
    const float* cw = INF(30) + (size_t)li * 4 * 3072; const float* pdtb = INF(32); const float* palog = INF(31);
    if (do_dn) for (int it = C.gw; it < T * 8; it += C.NGW) { const int tok = it >> 3, h = it & 7, tp = tok & 2047; float val[3][2];
#pragma unroll
        for (int s = 0; s < 3; ++s) { const int ch = s * 1024 + h * 128 + 2 * lane; float a0 = 0.f, a1 = 0.f;
#pragma unroll
            for (int k = 0; k < 4; ++k) { const int tt = tp - 3 + k; if (tt >= 0) { const unsigned w = *(const unsigned*)(H + (size_t)(tok - 3 + k) * HO + 1024 + ch); a0 += cw[k * 3072 + ch] * pg8::bf_lo(w); a1 += cw[k * 3072 + ch + 1] * pg8::bf_hi(w); } }
            val[s][0] = silu_f(a0); val[s][1] = silu_f(a1); }
        const float qn = 1.0f / sqrtf(wave_sum(val[0][0] * val[0][0] + val[0][1] * val[0][1]) + RMS_EPS) * 0.08838834764831845f;
        const float kn = 1.0f / sqrtf(wave_sum(val[1][0] * val[1][0] + val[1][1] * val[1][1]) + RMS_EPS);
        const size_t o = (size_t)tok * 1024 + h * 128 + 2 * lane;
        *(f32x2*)(QN + o) = (f32x2){val[0][0] * qn, val[0][1] * qn}; *(f32x2*)(KN + o) = (f32x2){val[1][0] * kn, val[1][1] * kn}; *(f32x2*)(VN + o) = (f32x2){val[2][0], val[2][1]};
        if (lane == 0) { const float braw = bf2f(H[(size_t)tok * HO + 5120 + h]), araw = bf2f(H[(size_t)tok * HO + 5128 + h]);
            BETA[tok * 8 + h] = 1.0f / (1.0f + expf(-braw));
            const float z = araw + pdtb[li * 8 + h]; const float sp = (z > 20.f) ? z : log1pf(expf(z));
            GG[tok * 8 + h] = -expf(palog[li * 8 + h]) * sp; } }
}
__device__ __forceinline__ void nv_odd_b(const Args& args, const Ctx& C0, int li, bool do_s5, bool do_dn) {
    const Ctx C = fresh(C0);
    unsigned char* ws = C.ws; const bf16* H = (const bf16*)(ws + WS_H); const f32x2* X5 = (const f32x2*)(ws + WS_SCR + SC_X5); bf16* YS = (bf16*)(ws + WS_SCR + SC_YS);
    const float* QN = (const float*)(ws + WS_SCR + SC_QN); const float* KN = (const float*)(ws + WS_SCR + SC_KN); const float* VN = (const float*)(ws + WS_SCR + SC_VN);
    const float* BETA = (const float*)(ws + WS_SCR + SC_BETA); const float* GG = (const float*)(ws + WS_SCR + SC_G); float* DOo = (float*)(ws + WS_SCR + SC_DO);
    if (C.bid < 32) { if (do_dn) { const int bh = C.bid, b = bh >> 3, h = bh & 7, e = C.tid >> 2, dq = C.tid & 3;
        float S[32];
#pragma unroll
        for (int d = 0; d < 32; ++d) S[d] = 0.f;
        for (int t = 0; t < SEQ; ++t) { const size_t tok = (size_t)b * 2048 + t; const float* k = KN + tok * 1024 + h * 128 + dq * 32; const float* q = QN + tok * 1024 + h * 128 + dq * 32;
            const float a = expf(GG[tok * 8 + h]), bt = BETA[tok * 8 + h], ve = VN[tok * 1024 + h * 128 + e];
            f32x4 kk[8];
#pragma unroll
            for (int d4 = 0; d4 < 8; ++d4) kk[d4] = *(const f32x4*)(k + 4 * d4);
            float dot = 0.f;
#pragma unroll
            for (int d4 = 0; d4 < 8; ++d4) dot += kk[d4].x * S[4 * d4] + kk[d4].y * S[4 * d4 + 1] + kk[d4].z * S[4 * d4 + 2] + kk[d4].w * S[4 * d4 + 3];
            dot = quad_sum(dot);
            const float c2 = bt * (ve - a * dot); float o = 0.f;
#pragma unroll
            for (int d4 = 0; d4 < 8; ++d4) { const f32x4 qq = *(const f32x4*)(q + 4 * d4);
                S[4 * d4] = a * S[4 * d4] + kk[d4].x * c2; S[4 * d4 + 1] = a * S[4 * d4 + 1] + kk[d4].y * c2; S[4 * d4 + 2] = a * S[4 * d4 + 2] + kk[d4].z * c2; S[4 * d4 + 3] = a * S[4 * d4 + 3] + kk[d4].w * c2;
                o += qq.x * S[4 * d4] + qq.y * S[4 * d4 + 1] + qq.z * S[4 * d4 + 2] + qq.w * S[4 * d4 + 3]; }
            o = quad_sum(o);
            if (dq == 0) DOo[tok * 1024 + h * 128 + e] = o; } } }
    else if (do_s5) { const size_t g0 = (size_t)(C.bid - 32) * NTHR + C.tid, gs = (size_t)(C.G - 32) * NTHR;
        const float* pcr = INF(24); const float* pci = INF(25); const float* pcd = INF(26);
        for (size_t i = g0; i < (size_t)T * 1024; i += gs) { const int tok = (int)(i >> 10), c = (int)(i & 1023), g = c >> 4, cc = c & 15;
            const f32x2* x = X5 + ((size_t)tok * 64 + g) * 64; const float* cr = pcr + ((size_t)(li * 64 + g) * 16 + cc) * 64; const float* ci = pci + ((size_t)(li * 64 + g) * 16 + cc) * 64; float s = 0.f;
            for (int p = 0; p < 64; ++p) { const f32x2 xv = x[p]; s += xv.x * cr[p] - xv.y * ci[p]; }
            s += pcd[(li * 64 + g) * 16 + cc] * bf2f(H[(size_t)tok * HO + c]);
            YS[i] = (bf16)f2bf(0.5f * s * (1.0f + erff(s * 0.70710678118654752f))); } }
}
__device__ __forceinline__ void phase_odd_normgate(const Args& args, const Ctx& C0, int li) {
    const Ctx C = fresh(C0);
    unsigned char* ws = C.ws; const bf16* H = (const bf16*)(ws + WS_H); bf16* YC = (bf16*)(ws + WS_YC); const float* DOo = (const float*)(ws + WS_SCR + SC_DO);
    const float* ng = INF(33) + li * 128;
    for (int it = C.gw; it < T * 8; it += C.NGW) { const int tok = it >> 3, h = it & 7; const int c0 = h * 128 + 2 * C.lane;
        const f32x2 v = *(const f32x2*)(DOo + (size_t)tok * 1024 + c0);
        const float r = 1.0f / sqrtf(wave_sum(v.x * v.x + v.y * v.y) * (1.f / 128.f) + RMS_EPS);
        const unsigned gw = *(const unsigned*)(H + (size_t)tok * HO + 4096 + c0);
        *(unsigned*)(YC + (size_t)tok * 2048 + 1024 + c0) = pk2(v.x * r * ng[2 * C.lane] * silu_f(pg8::bf_lo(gw)), v.y * r * ng[2 * C.lane + 1] * silu_f(pg8::bf_hi(gw))); }
}

__host__ __device__ constexpr bool slot_active(int layer, int slot) {
    const bool odd = layer & 1;
    if (slot == 0 || (slot >= 9 && slot <= 14)) return true;
    if (!odd) { if (slot == 1) return !(FAST_GATE && FAST_RET); if (slot == 2) return true; return (slot == 3 || slot == 4) && !FAST_RET; }
    return slot >= 1 && slot <= 2;
}
constexpr int PH_END = 1 + 16 * DEPTH;
#ifdef TEST_SITE
#define SITE_ON(n) (TEST_SITE == (n))
#else
#define SITE_ON(n) 1
#endif

__global__ void __launch_bounds__(NTHR, 2) trunk_fwd(Args args) {
    extern __shared__ __attribute__((aligned(16))) unsigned char lds_raw[];
    Ctx C;
    C.lds = (LAS unsigned char*)lds_raw; C.tid = threadIdx.x; C.lane = C.tid & 63; C.wave = __builtin_amdgcn_readfirstlane(C.tid >> 6); C.G = gridDim.x;
    C.bid = blockIdx.x; C.gw = blockIdx.x * NWAVES + C.wave; C.NGW = C.G * NWAVES; C.gtid = (size_t)blockIdx.x * NTHR + C.tid; C.gsz = (size_t)C.G * NTHR;
    volatile LAS unsigned* MISC = (volatile LAS unsigned*)(C.lds + MISC_OFF);
    if (C.tid < 64) MISC[C.tid] = 0u;
    __syncthreads();
    C.ws = args.ws;
    unsigned* ctl = (unsigned*)(args.ws + WS_CTL);
    const int lo = args.ph_lo, hi = args.ph_hi; const bool fused = (hi - lo) > 1;
    XcdBarrier bar; bar.bar = ctl + CW_BAR; bar.x = 0; bar.st = nullptr;
    if (fused) bar = xcd_barrier_post(ctl + CW_BAR, MISC);
#define RUN(k) (lo <= (k) && (k) < hi)
#define RUNS(slot) (RUN(base + (slot)) && slot_active(layer, (slot)))
#define SEAM(k) do { if (fused && (k) + 1 < PH_END - 1) xcd_barrier(bar); } while (0)

    #if SITE_ON(0)
        if (RUN(0)) { for (int rp = 0; rp < DUPN(0); ++rp) { phase_prologue(args, C); __syncthreads(); } SEAM(0); }
#endif


    for (int layer = 0; layer < DEPTH; ++layer) {
        const int base = 1 + 16 * layer, li = layer >> 1; const bool odd = layer & 1;
#define WSL(name) unsigned long long name##_z = 0ull; asm volatile("" : "+s"(name##_z)); unsigned char* name = args.ws + name##_z
        #if SITE_ON(1)
        if (RUNS(0)) { WSL(ws);
            pg8::StaticOrder S; S.init(ws + WS_XB, odd ? (ws + WS_WIO + li * SZ_WIO) : (ws + WS_WIE + li * SZ_WIE), 2048, 32, odd ? 21 : 24, C.G, (int)blockIdx.x);
            pg8::EpiWin E{(bf16*)(ws + WS_H), odd ? HO : HE, odd ? 0 : 8, 0, (!odd && FAST_RET) ? 16 : 0, 12, (const float*)(ws + WS_COS), (const float*)(ws + WS_SIN)};
            if (!odd && FAST_RET) E.rot_lo = 8;
            for (int rp = 0; rp < DUPN(1); ++rp) pg8::gemm_phase<pg8::EpiWin, pg8::StaticOrder, true, true>(C.lds, 2048, S, E);
            SEAM(base + 0);
        }
#endif

        if (!odd) {
            #if SITE_ON(2)
        if (RUNS(1)) { nv_even_prep(args, C, li, !FAST_GATE, !FAST_RET); SEAM(base + 1); }
#endif

            #if SITE_ON(3)
        if (RUNS(2)) { if (!(FAST_GATE && FAST_RET)) nv_even_a(args, C, li, !FAST_GATE, !FAST_RET); if (FAST_GATE || FAST_RET) for (int rp = 0; rp < DUPN(6); ++rp) fast_even_mix(args, C, li); SEAM(base + 2); }
#endif

            #if SITE_ON(4)
        if (RUNS(3)) { nv_even_b(args, C); SEAM(base + 3); }
#endif

            #if SITE_ON(5)
        if (RUNS(4)) { nv_even_c(args, C); SEAM(base + 4); }
#endif

        } else {
            #if SITE_ON(6)
        if (RUNS(1)) { if (!(FAST_S5 && FAST_DN)) nv_odd_a(args, C, li, !FAST_S5, !FAST_DN); if (FAST_DN) for (int rp = 0; rp < DUPN(7); ++rp) fast_odd_mix_a(args, C, li); SEAM(base + 1); }
#endif

            #if SITE_ON(7)
        if (RUNS(2)) { if (!(FAST_S5 && FAST_DN)) nv_odd_b(args, C, li, !FAST_S5, !FAST_DN); if (FAST_S5 || FAST_DN) for (int rp = 0; rp < DUPN(8); ++rp) fast_odd_mix_b(args, C, li); SEAM(base + 2); }
#endif

        }
        #if SITE_ON(8)
        if (RUNS(9)) { WSL(ws);
            for (int rp = 0; rp < DUPN(3); ++rp) { if (!odd) phase_even_normgate(args, C, li);
            else {
                pg8::StaticOrder S; S.init(ws + WS_SCR + SC_YS, ws + WS_WGL + li * SZ_WGL, 1024, 32, 4, C.G, (int)blockIdx.x);
                pg8::EpiGlu E{(const bf16*)(ws + WS_SCR + SC_YS), INF(29) + li * 1024, (bf16*)(ws + WS_YC)};
                pg8::gemm_phase<pg8::EpiGlu, pg8::StaticOrder, true, true>(C.lds, 1024, S, E);
                phase_odd_normgate(args, C, li);
            } }
            SEAM(base + 9);
        }
#endif

        #if SITE_ON(9)
        if (RUNS(10)) { WSL(ws);
            pg8::StaticOrder S; S.init(ws + WS_YC, odd ? (ws + WS_WOO + li * SZ_WO) : (ws + WS_WOE + li * SZ_WO), 2048, 32, 8, C.G, (int)blockIdx.x);
            pg8::EpiWout E{(const bf16*)(ws + WS_XB), (bf16*)(ws + WS_Z), DN_ALPHA};
            for (int rp = 0; rp < DUPN(2); ++rp) pg8::gemm_phase<pg8::EpiWout, pg8::StaticOrder, true, true>(C.lds, 2048, S, E);
            SEAM(base + 10);
        }
#endif

        #if SITE_ON(10)
        if (RUNS(11)) { phase_ln_route(args, C, layer); SEAM(base + 11); }
#endif

        if (RUNS(12) || RUNS(13)) { WSL(ws);
            LAS int* tab = (LAS int*)(C.lds + MISC_OFF + 64);
            __syncthreads();
            if (C.tid == 0) { int pre = 0; const unsigned* cnt = (const unsigned*)(ws + WS_CTL) + CW_CNT + layer * 16 * 64;
                for (int e = 0; e < 16; ++e) { const int n = (int)__hip_atomic_load(cnt + e * 64, __ATOMIC_RELAXED, __HIP_MEMORY_SCOPE_AGENT); tab[e] = pre; tab[17 + e] = n; pre += (n + 255) >> 8; }
                tab[16] = pre; }
            __syncthreads();
            #if SITE_ON(11)
        if (RUNS(12)) {
                pg8::MoeOrder S{tab, (const char*)(ws + WS_XS), (const char*)(ws + WS_MW1 + (size_t)layer * 16 * SZ_MW1), (size_t)8192 * 2048 * 2, SZ_MW1, (size_t)256 * 2048 * 2, (size_t)256 * 2048 * 2, C.G, (int)blockIdx.x};
                pg8::EpiMoe1 E{(bf16*)(ws + WS_ACT)};
                for (int rp = 0; rp < DUPN(4); ++rp) pg8::gemm_phase<pg8::EpiMoe1, pg8::MoeOrder, true, true>(C.lds, 2048, S, E);
                SEAM(base + 12);
            }
#endif

            #if SITE_ON(12)
        if (RUNS(13)) {
                pg8::MoeOrder S{tab, (const char*)(ws + WS_ACT), (const char*)(ws + WS_MW2 + (size_t)layer * 16 * SZ_MW2), (size_t)8192 * 1024 * 2, SZ_MW2, (size_t)256 * 1024 * 2, (size_t)256 * 1024 * 2, C.G, (int)blockIdx.x};
                pg8::EpiMoe2 E{(const int*)(ws + WS_DST), (const float*)(ws + WS_GATE), (bf16*)(ws + WS_YB)};
                for (int rp = 0; rp < DUPN(5); ++rp) pg8::gemm_phase<pg8::EpiMoe2, pg8::MoeOrder, true, true>(C.lds, 1024, S, E);
                SEAM(base + 13);
            }
#endif

        }
        #if SITE_ON(13)
        if (RUNS(14)) { phase_ln_ffn(args, C, layer); SEAM(base + 14); }
#endif

    }
#undef RUN
#undef RUNS
#undef SEAM
}

extern "C" void kernel_launch(void* const* d_in, const int* in_sizes, int n_in, void* d_out, int out_size, void* d_ws, size_t ws_size, hipStream_t stream) {
    static int grid = 0;
    if (grid == 0) {
        if (n_in != 34 || out_size != T * D || ws_size < WS_END) { fprintf(stderr, "kernel_launch: unexpected shapes (n_in %d, out %d, ws %zu < %zu)\n", n_in, out_size, ws_size, (size_t)WS_END); grid = -1; return; }
        int dev = 0, cus = 0, per_cu = 0;
        if (hipGetDevice(&dev) != hipSuccess || hipDeviceGetAttribute(&cus, hipDeviceAttributeMultiprocessorCount, dev) != hipSuccess) { grid = -1; return; }
        if (hipFuncSetAttribute((const void*)trunk_fwd, hipFuncAttributeMaxDynamicSharedMemorySize, LDS_BYTES) != hipSuccess) { fprintf(stderr, "kernel_launch: hipFuncSetAttribute failed\n"); grid = -1; return; }
        if (hipOccupancyMaxActiveBlocksPerMultiprocessor(&per_cu, (const void*)trunk_fwd, NTHR, LDS_BYTES) != hipSuccess || per_cu < 1) { fprintf(stderr, "kernel_launch: occupancy query says %d blocks per CU\n", per_cu); }
        (void)hipGetLastError();
        grid = cus;
    }
    if (grid < 0) return;
    (void)in_sizes;
    if (hipMemsetAsync((char*)d_ws + WS_CTL, 0, CTL_BYTES, stream) != hipSuccess) return;
    Args a{};
    for (int i = 0; i < 34; ++i) a.in[i] = d_in[i];
    a.out = (float*)d_out; a.ws = (unsigned char*)d_ws;
#if MK_ONE_LAUNCH
    a.ph_lo = 0; a.ph_hi = PH_END;
    hipLaunchKernelGGL(trunk_fwd, dim3(grid), dim3(NTHR), LDS_BYTES, stream, a);
#else
    for (int ph = 0; ph < PH_END; ++ph) {
        if (ph > 0 && !slot_active((ph - 1) / 16, (ph - 1) % 16)) continue;
        a.ph_lo = ph; a.ph_hi = ph + 1;
        hipLaunchKernelGGL(trunk_fwd, dim3(grid), dim3(NTHR), LDS_BYTES, stream, a);
    }
#endif
}
```
